# Optimizing an MI355X kernel written in HIP

```python
import jax, jax.numpy as jnp
from jax import lax
import numpy as np

D_MODEL = 1024
BATCH = 8
SEQ = 4096
DEPTH = 1

DN_HEADS = 8
DN_HEAD_DIM = 128
DN_WIDTH = DN_HEADS * DN_HEAD_DIM
DN_CONV = 4
DN_CHUNK = 64
SB_HEADS = 8
SB_HEAD_DIM = 128
SB_WIDTH = SB_HEADS * SB_HEAD_DIM
SB_BLOCK = 128
D_FF = 2816
FFN_CONV = 3
EPS = 1e-6

DN_QKV_END = 3 * DN_WIDTH
DN_A_END = DN_QKV_END + DN_HEADS
DN_B_END = DN_A_END + DN_HEADS
DN_G_END = DN_B_END + DN_WIDTH
SB_QKV_END = DN_G_END + 3 * SB_WIDTH
IN_WIDTH = SB_QKV_END + 2 * D_MODEL
SPLIT_IDX = (DN_QKV_END, DN_A_END, DN_B_END, DN_G_END, SB_QKV_END)

kernel_name = 'hybrid_gdn_stickbreak_convffn'


def rmsnorm(x, w):
    xf = x.astype(jnp.float32)
    y = xf * lax.rsqrt(jnp.mean(xf * xf, axis=-1, keepdims=True) + EPS)
    return (y * w.astype(jnp.float32)).astype(x.dtype)


def l2norm(x):
    xf = x.astype(jnp.float32)
    return (xf * lax.rsqrt(jnp.sum(xf * xf, axis=-1, keepdims=True) + EPS)).astype(x.dtype)


def causal_dwconv(x, w):
    K = w.shape[0]
    T = x.shape[1]
    xp = jnp.pad(x, ((0, 0), (K - 1, 0), (0, 0)))
    y = w[0] * xp[:, 0:T]
    for i in range(1, K):
        y = y + w[i] * xp[:, i:i + T]
    return y


def to_heads(t, n_heads, head_dim):
    B, T, _ = t.shape
    return t.reshape(B, T, n_heads, head_dim).transpose(0, 2, 1, 3)


def gated_delta_rule(q, k, v, g, beta):
    out_dtype = v.dtype
    q, k, v, g, beta = (t.astype(jnp.float32) for t in (q, k, v, g, beta))
    B, H, T, dk = q.shape
    dv = v.shape[-1]
    C = DN_CHUNK
    N = T // C
    q = q * (dk ** -0.5)
    rs = lambda t: t.reshape(B, H, N, C, *t.shape[3:])
    q, k, v, g, beta = rs(q), rs(k), rs(v), rs(g), rs(beta)
    g = jnp.cumsum(g, axis=-1)
    k_beta = k * beta[..., None]
    v_beta = v * beta[..., None]
    lower = jnp.tril(jnp.ones((C, C), dtype=bool))
    strict = jnp.tril(jnp.ones((C, C), dtype=bool), -1)
    diff = g[..., :, None] - g[..., None, :]
    decay = jnp.where(lower, jnp.exp(jnp.where(lower, diff, 0.0)), 0.0)
    L = jnp.where(strict, jnp.einsum('bhncd,bhnsd->bhncs', k_beta, k) * decay, 0.0)
    rhs = jnp.concatenate([v_beta, k_beta * jnp.exp(g)[..., None]], axis=-1)
    sol = lax.linalg.triangular_solve(L, rhs, left_side=True, lower=True, unit_diagonal=True)
    u = sol[..., :dv]
    w = sol[..., dv:]
    a_qk = jnp.where(lower, jnp.einsum('bhncd,bhnsd->bhncs', q, k) * decay, 0.0)

    def step(S, xs):
        q_i, k_i, u_i, w_i, g_i, a_i = xs
        v_new = u_i - jnp.einsum('bhcd,bhde->bhce', w_i, S)
        o_i = (jnp.einsum('bhcd,bhde->bhce', q_i * jnp.exp(g_i)[..., None], S)
               + jnp.einsum('bhcs,bhse->bhce', a_i, v_new))
        g_last = g_i[..., -1]
        S = (S * jnp.exp(g_last)[..., None, None]
             + jnp.einsum('bhcd,bhce->bhde', k_i * jnp.exp(g_last[..., None] - g_i)[..., None], v_new))
        return S, o_i

    xs = tuple(jnp.moveaxis(t, 2, 0) for t in (q, k, u, w, g, a_qk))
    S0 = jnp.zeros((B, H, dk, dv), jnp.float32)
    _, o = lax.scan(step, S0, xs)
    o = jnp.moveaxis(o, 0, 2).reshape(B, H, T, dv)
    return o.astype(out_dtype)


def stick_breaking_attention(q, k, v):
    B, H, T, d = q.shape
    nb = T // SB_BLOCK
    scale = d ** -0.5
    qb = q.reshape(B, H, nb, SB_BLOCK, d).transpose(2, 0, 1, 3, 4)
    key_pos = jnp.arange(T)

    def block(args):
        q_blk, i = args
        z = jnp.einsum('bhqd,bhkd->bhqk', q_blk, k).astype(jnp.float32) * scale
        q_pos = i * SB_BLOCK + jnp.arange(SB_BLOCK)
        mask = key_pos[None, :] < q_pos[:, None]
        log_keep = jnp.where(mask, jax.nn.log_sigmoid(-z), 0.0)
        between = lax.cumsum(log_keep, axis=3, reverse=True) - log_keep
        log_a = jax.nn.log_sigmoid(z) + between
        a = jnp.where(mask, jnp.exp(log_a), 0.0)
        return jnp.einsum('bhqk,bhkd->bhqd', a.astype(v.dtype), v)

    o = lax.map(block, (qb, jnp.arange(nb)))
    return o.transpose(1, 2, 0, 3, 4).reshape(B, H, T, d)


def setup_inputs(seed: int = 0) -> dict:
    key = jax.random.key(seed)
    ks = jax.random.split(key, 20)
    L = DEPTH
    nrm = lambda k, shape, fan_in: jax.random.normal(k, shape, jnp.float32) * (fan_in ** -0.5)
    gain = lambda k, shape: 1.0 + 0.02 * jax.random.normal(k, shape, jnp.float32)
    x = jax.random.normal(ks[0], (BATCH, SEQ, D_MODEL), jnp.float32)
    norm1_w = gain(ks[1], (L, D_MODEL))
    w_in = nrm(ks[2], (L, D_MODEL, IN_WIDTH), D_MODEL)
    dn_conv_w = nrm(ks[3], (L, DN_CONV, 3 * DN_WIDTH), DN_CONV)
    dn_A_log = jnp.log(jax.random.uniform(ks[4], (L, DN_HEADS), jnp.float32, 1.0, 16.0))
    dt = jnp.exp(jax.random.uniform(ks[5], (L, DN_HEADS), jnp.float32, np.log(1e-3), np.log(1e-1)))
    dn_dt_bias = dt + jnp.log(-jnp.expm1(-dt))
    dn_norm_w = gain(ks[6], (L, DN_HEAD_DIM))
    w_proj_dn = nrm(ks[7], (L, DN_WIDTH, D_MODEL), DN_WIDTH)
    w_proj_sb = nrm(ks[8], (L, SB_WIDTH, D_MODEL), SB_WIDTH)
    w_out = nrm(ks[9], (L, D_MODEL, D_MODEL), D_MODEL)
    norm2_w = gain(ks[10], (L, D_MODEL))
    ffn_w_up = nrm(ks[11], (L, D_MODEL, 2 * D_FF), D_MODEL)
    ffn_conv_w = nrm(ks[12], (L, FFN_CONV, 2 * D_FF), FFN_CONV)
    ffn_w_down = nrm(ks[13], (L, D_FF, D_MODEL), D_FF)
    norm_f_w = gain(ks[14], (D_MODEL,))
    return {'x': x, 'norm1_w': norm1_w, 'w_in': w_in, 'dn_conv_w': dn_conv_w,
            'dn_A_log': dn_A_log, 'dn_dt_bias': dn_dt_bias, 'dn_norm_w': dn_norm_w,
            'w_proj_dn': w_proj_dn, 'w_proj_sb': w_proj_sb, 'w_out': w_out,
            'norm2_w': norm2_w, 'ffn_w_up': ffn_w_up, 'ffn_conv_w': ffn_conv_w,
            'ffn_w_down': ffn_w_down, 'norm_f_w': norm_f_w}


def reference(x, norm1_w, w_in, dn_conv_w, dn_A_log, dn_dt_bias, dn_norm_w,
              w_proj_dn, w_proj_sb, w_out, norm2_w, ffn_w_up, ffn_conv_w,
              ffn_w_down, norm_f_w):
    B, T, _ = x.shape
    for l in range(DEPTH):
        n1 = rmsnorm(x, norm1_w[l])
        h = n1 @ w_in[l]
        dn_qkv, dn_a, dn_b, dn_gate, sb_qkv, gate_logits = jnp.split(h, SPLIT_IDX, axis=-1)

        dn_qkv = jax.nn.silu(causal_dwconv(dn_qkv, dn_conv_w[l]))
        dq, dk, dv = jnp.split(dn_qkv, 3, axis=-1)
        dq = l2norm(to_heads(dq, DN_HEADS, DN_HEAD_DIM))
        dk = l2norm(to_heads(dk, DN_HEADS, DN_HEAD_DIM))
        dv = to_heads(dv, DN_HEADS, DN_HEAD_DIM)
        beta = jax.nn.sigmoid(dn_b.astype(jnp.float32)).transpose(0, 2, 1)
        g = (-jnp.exp(dn_A_log[l].astype(jnp.float32))
             * jax.nn.softplus(dn_a.astype(jnp.float32) + dn_dt_bias[l].astype(jnp.float32))).transpose(0, 2, 1)
        o_dn = gated_delta_rule(dq, dk, dv, g, beta)
        o_dn = rmsnorm(o_dn, dn_norm_w[l]).transpose(0, 2, 1, 3)
        o_dn = o_dn * jax.nn.silu(dn_gate.reshape(B, T, DN_HEADS, DN_HEAD_DIM))
        o_dn = o_dn.reshape(B, T, DN_WIDTH)

        sq, sk, sv = jnp.split(sb_qkv, 3, axis=-1)
        o_sb = stick_breaking_attention(to_heads(sq, SB_HEADS, SB_HEAD_DIM),
                                        to_heads(sk, SB_HEADS, SB_HEAD_DIM),
                                        to_heads(sv, SB_HEADS, SB_HEAD_DIM))
        o_sb = o_sb.transpose(0, 2, 1, 3).reshape(B, T, SB_WIDTH)

        gate_dn, gate_sb = jnp.split(jax.nn.sigmoid(gate_logits), 2, axis=-1)
        mixed = gate_dn * (o_dn @ w_proj_dn[l]) + gate_sb * (o_sb @ w_proj_sb[l])
        x = x + mixed @ w_out[l]

        n2 = rmsnorm(x, norm2_w[l])
        u = causal_dwconv(n2 @ ffn_w_up[l], ffn_conv_w[l])
        gate, up = jnp.split(u, 2, axis=-1)
        x = x + (jax.nn.silu(gate) * up) @ ffn_w_down[l]
    return rmsnorm(x, norm_f_w)
```

```cpp
#include <hip/hip_runtime.h>
#include <hip/hip_cooperative_groups.h>
#include <cstdio>
#include <cstdint>
namespace cg = cooperative_groups;

#define LAS __attribute__((address_space(3)))
typedef unsigned short bf16_t;
typedef short bf16x8 __attribute__((ext_vector_type(8)));
typedef float f32x4 __attribute__((ext_vector_type(4)));
typedef float f32x16 __attribute__((ext_vector_type(16)));
typedef unsigned u32x4 __attribute__((ext_vector_type(4)));

constexpr int DM = 1024, SEQ = 4096, NBATCH = 8, MTOT = NBATCH * SEQ;
constexpr int BG = 4, MG = BG * SEQ, NGRP = NBATCH / BG;
constexpr int HW = 9216, NIN_PAD = 9472, FF = 2816, FF2 = 5632;
constexpr int HC_DNQ = 0, HC_DNG = 3072, HC_SBQ = 4096, HC_SBK = 5120, HC_SBV = 6144, HC_GDN = 7168, HC_GSB = 8192;
constexpr float EPS = 1e-6f;
constexpr size_t MiB = 1u << 20;
constexpr size_t WS_WIN = 0, WS_WPA = 19 * MiB, WS_WPB = 21 * MiB, WS_WOUT = 23 * MiB, WS_WUP = 25 * MiB, WS_WDOWN = 36 * MiB;
constexpr size_t WS_AB = 42 * MiB, WS_EG = 43 * MiB, WS_BETA = 43 * MiB + 512 * 1024, WS_N1 = 44 * MiB, WS_H = 108 * MiB, WS_DNQ = 396 * MiB, WS_END = 492 * MiB;
constexpr size_t WS_U = 108 * MiB, WS_HACT = 284 * MiB;
constexpr int LDS_BYTES = 147456;
constexpr int NTHREADS = 512, NWAVES = 8;

__device__ __forceinline__ unsigned f2bf(float f) { unsigned u = __builtin_bit_cast(unsigned, f); return (u + 0x7fffu + ((u >> 16) & 1u)) >> 16; }
__device__ __forceinline__ unsigned pk2(float lo, float hi) { return f2bf(lo) | (f2bf(hi) << 16); }
__device__ __forceinline__ float bflo(unsigned u) { return __builtin_bit_cast(float, u << 16); }
__device__ __forceinline__ float bfhi(unsigned u) { return __builtin_bit_cast(float, u & 0xffff0000u); }
__device__ __forceinline__ float bf2f(unsigned short h) { return __builtin_bit_cast(float, (unsigned)h << 16); }
__device__ __forceinline__ float sigmoidf_(float x) { return 1.f / (1.f + __expf(-x)); }
__device__ __forceinline__ void unpack8(u32x4 u, float* f) {
    f[0] = bflo(u.x); f[1] = bfhi(u.x); f[2] = bflo(u.y); f[3] = bfhi(u.y); f[4] = bflo(u.z); f[5] = bfhi(u.z); f[6] = bflo(u.w); f[7] = bfhi(u.w);
}
__device__ __forceinline__ u32x4 pack8(const float* f) { u32x4 o; o.x = pk2(f[0], f[1]); o.y = pk2(f[2], f[3]); o.z = pk2(f[4], f[5]); o.w = pk2(f[6], f[7]); return o; }

__device__ __forceinline__ int opaque_tid() { int t = threadIdx.x; asm volatile("" : "+v"(t)); return t; }

namespace pg8 {
constexpr int BM = 256, BK = 64, HALF = 128, HTB = HALF * BK * 2, NXCD = 8, WGM = 8;
__host__ __device__ __forceinline__ int lds_byte(int r, int c) { const int st = (r >> 4) * 2 + (c >> 5), rr = r & 15, cc = c & 31, ob = rr * 64 + cc * 2; return st * 1024 + (ob ^ (((ob >> 9) & 1) << 5)); }
__host__ __device__ __forceinline__ void stage_rc(int b, int& R, int& C) { const int st = b / 1024, sb = b % 1024, swz = sb ^ (((sb >> 9) & 1) << 5); R = (st >> 1) * 16 + swz / 64; C = (st & 1) * 32 + (swz % 64) / 2; }
__host__ __device__ __forceinline__ int perm32(int rho) { const int n = rho >> 4, i = rho & 15; return 8 * (i >> 2) + 4 * n + (i & 3); }
struct Unit { int pm, pn; };
struct Gemm { const bf16_t* A; const bf16_t* Bt; int M, N, K, lda; };
struct StaticOrder {
    int nM, nN, nwg, G, c;
    __device__ void init(int M, int N, int G_, int c_) { nM = M / BM; nN = N / BM; nwg = nM * nN; G = G_; c = c_; }
    __device__ bool next(int i, Unit& u) const {
        const long L = (long)i * G + c; if (L >= nwg) return false;
        int wgid = (int)L; { const int q = nwg / NXCD, r = nwg % NXCD, xcd = wgid % NXCD, off = wgid / NXCD; wgid = (xcd < r ? xcd * (q + 1) : r * (q + 1) + (xcd - r) * q) + off; }
        const int nig = WGM * nN, gid = wgid / nig, fm = gid * WGM, gsz = (nM - fm) < WGM ? (nM - fm) : WGM;
        u.pm = fm + ((wgid % nig) % gsz); u.pn = (wgid % nig) / gsz; return true;
    }
};
__device__ __forceinline__ unsigned cvt_pk_bf16(float lo, float hi) { unsigned r; asm volatile("v_cvt_pk_bf16_f32 %0, %1, %2" : "=v"(r) : "v"(lo), "v"(hi)); return r; }

template <class Epi>
__device__ __forceinline__ void gemm_phase(LAS unsigned char* lds, const Gemm g, const StaticOrder& S, const Epi& E) {
    const int tid = opaque_tid(), wid = __builtin_amdgcn_readfirstlane(tid >> 6), lane = tid & 63, wr = wid >> 2, wc = wid & 3, fr = lane & 15, fq = lane >> 4;
    const int K = g.K, nt = K / BK, lda = g.lda;
    unsigned voffA[2], voffB[2];
#pragma unroll
    for (int i = 0; i < 2; ++i) { int R, C; stage_rc(tid * 16 + i * 8192, R, C); const int Rb = (R & ~31) + perm32(R & 31);
        voffA[i] = (unsigned)(R * lda + C) * 2u; voffB[i] = (unsigned)(Rb * K + C) * 2u; }
    const size_t kstep = (size_t)(BK * 2);
    const size_t hstepA = (size_t)HALF * lda * 2, hstepB = (size_t)HALF * K * 2;
    const size_t tstepA = 2 * hstepA, tstepB = 2 * hstepB;
    const unsigned ldsw = (unsigned)wid * 1024u;
    const int aoff = lds_byte(wr * 64 + fr, fq * 8), boff = lds_byte(wc * 32 + fr, fq * 8);
#define PG8_SA(b, h) (((b) * 2 + (h)) * HTB)
#define PG8_SB(b, h) ((4 + (b) * 2 + (h)) * HTB)
#define PG8_STAGE(bufoff, gbase, voff) do { _Pragma("unroll") for (int _i = 0; _i < 2; ++_i) \
        __builtin_amdgcn_global_load_lds((const unsigned*)((const char*)(gbase) + (voff)[_i]), (LAS unsigned*)(lds + (bufoff) + ldsw + _i * 8192), 16, 0, 0); } while (0)
#define PG8_LDA(dst, b, h) do { _Pragma("unroll") for (int m = 0; m < 4; ++m) _Pragma("unroll") for (int k = 0; k < 2; ++k) dst[m][k] = *(const LAS bf16x8*)(lds + PG8_SA(b, h) + aoff + m * 2048 + k * 1024); } while (0)
#define PG8_LDB(dst, b, h) do { _Pragma("unroll") for (int n = 0; n < 2; ++n) _Pragma("unroll") for (int k = 0; k < 2; ++k) dst[n][k] = *(const LAS bf16x8*)(lds + PG8_SB(b, h) + boff + n * 2048 + k * 1024); } while (0)
#define PG8_MMA(ai, bj, At, Bt) do { __builtin_amdgcn_s_setprio(1); _Pragma("unroll") for (int m = 0; m < 4; ++m) _Pragma("unroll") for (int n = 0; n < 2; ++n) _Pragma("unroll") for (int k = 0; k < 2; ++k) \
        acc[ai][bj][m][n] = __builtin_amdgcn_mfma_f32_16x16x32_bf16(Bt[n][k], At[m][k], acc[ai][bj][m][n], 0, 0, 0); __builtin_amdgcn_s_setprio(0); } while (0)
#define PG8_WAIT_V(n) asm volatile("s_waitcnt vmcnt(" #n ")" ::: "memory")
#define PG8_WAIT_L(n) asm volatile("s_waitcnt lgkmcnt(" #n ")" ::: "memory")
#define PG8_BAR __builtin_amdgcn_s_barrier()
#define PG8_SCHED __builtin_amdgcn_sched_barrier(0)
    Unit cur, nxt; int ui = 0;
    if (!S.next(0, cur)) return;
    f32x4 acc[2][2][4][2];
#pragma unroll
    for (int a = 0; a < 2; ++a)
#pragma unroll
        for (int b = 0; b < 2; ++b)
#pragma unroll
            for (int m = 0; m < 4; ++m)
#pragma unroll
                for (int n = 0; n < 2; ++n) acc[a][b][m][n] = (f32x4){0.f, 0.f, 0.f, 0.f};
    bf16x8 At[4][2], B0[2][2], B1[2][2];
    const char* cA = (const char*)g.A + (size_t)cur.pm * tstepA; const char* cB = (const char*)g.Bt + (size_t)cur.pn * tstepB;
    PG8_STAGE(PG8_SB(0, 0), cB, voffB); PG8_STAGE(PG8_SB(0, 1), cB + hstepB, voffB); PG8_STAGE(PG8_SA(0, 0), cA, voffA); PG8_STAGE(PG8_SA(0, 1), cA + hstepA, voffA);
    if (wr == 1) PG8_BAR;
    PG8_WAIT_V(2); PG8_BAR;
    PG8_STAGE(PG8_SB(1, 0), cB + kstep, voffB); PG8_STAGE(PG8_SA(1, 0), cA + kstep, voffA); PG8_STAGE(PG8_SB(1, 1), cB + hstepB + kstep, voffB);
    PG8_WAIT_V(6); PG8_BAR;
    for (;;) {
        const bool has_next = S.next(ui + 1, nxt);
        const char* nA = has_next ? (const char*)g.A + (size_t)nxt.pm * tstepA : cA; const char* nB = has_next ? (const char*)g.Bt + (size_t)nxt.pn * tstepB : cB;
        for (int t = 0; t < nt; t += 2) {
            const bool last = (t == nt - 2);
            const char* a1 = cA + (size_t)(t + 1) * kstep;
            const char* a2 = last ? nA : cA + (size_t)(t + 2) * kstep; const char* b2 = last ? nB : cB + (size_t)(t + 2) * kstep;
            const char* a3 = a2 + kstep; const char* b3 = b2 + kstep;
            PG8_LDB(B0, 0, 0); PG8_LDB(B1, 0, 1); PG8_SCHED; PG8_LDA(At, 0, 0); PG8_STAGE(PG8_SA(1, 1), a1 + hstepA, voffA);
            PG8_WAIT_V(8); PG8_WAIT_L(0); PG8_BAR; PG8_MMA(0, 0, At, B0); PG8_MMA(0, 1, At, B1); PG8_BAR; PG8_SCHED;
            PG8_LDA(At, 0, 1); PG8_STAGE(PG8_SB(0, 0), b2, voffB); PG8_STAGE(PG8_SB(0, 1), b2 + hstepB, voffB); PG8_STAGE(PG8_SA(0, 0), a2, voffA);
            PG8_WAIT_V(8); PG8_WAIT_L(0); PG8_BAR; PG8_MMA(1, 0, At, B0); PG8_MMA(1, 1, At, B1); PG8_BAR; PG8_SCHED;
            PG8_LDB(B0, 1, 0); PG8_LDB(B1, 1, 1); PG8_SCHED; PG8_LDA(At, 1, 0); PG8_STAGE(PG8_SA(0, 1), a2 + hstepA, voffA);
            PG8_WAIT_V(8); PG8_WAIT_L(0); PG8_BAR; PG8_MMA(0, 0, At, B0); PG8_MMA(0, 1, At, B1); PG8_BAR; PG8_SCHED;
            PG8_LDA(At, 1, 1); PG8_STAGE(PG8_SB(1, 0), b3, voffB); PG8_STAGE(PG8_SB(1, 1), b3 + hstepB, voffB); PG8_STAGE(PG8_SA(1, 0), a3, voffA);
            PG8_WAIT_V(8); PG8_WAIT_L(0); PG8_BAR; PG8_MMA(1, 0, At, B0); PG8_MMA(1, 1, At, B1); PG8_BAR; PG8_SCHED;
        }
        if (wr == 0) PG8_BAR;
        E(acc, cur, wr, wc, fr, fq);
        if (!has_next) break;
#pragma unroll
        for (int a = 0; a < 2; ++a)
#pragma unroll
            for (int b = 0; b < 2; ++b)
#pragma unroll
                for (int m = 0; m < 4; ++m)
#pragma unroll
                    for (int n = 0; n < 2; ++n) acc[a][b][m][n] = (f32x4){0.f, 0.f, 0.f, 0.f};
        cur = nxt; cA = nA; cB = nB; ++ui;
        if (wr == 1) PG8_BAR;
    }
    PG8_WAIT_V(0);
    PG8_BAR;
#undef PG8_SA
#undef PG8_SB
#undef PG8_STAGE
#undef PG8_LDA
#undef PG8_LDB
#undef PG8_MMA
#undef PG8_WAIT_V
#undef PG8_WAIT_L
#undef PG8_BAR
#undef PG8_SCHED
}
}

template <int MODE> struct Epi {
    bf16_t* O; int ldc; float* F; const float* R;
    __device__ __forceinline__ void operator()(const f32x4 (&acc)[2][2][4][2], const pg8::Unit& u, int wr, int wc, int fr, int fq) const {
        const int row0 = u.pm * 256 + wr * 64 + fr; const int col0 = u.pn * 256 + wc * 32 + 8 * fq;
#pragma unroll
        for (int ai = 0; ai < 2; ++ai)
#pragma unroll
            for (int m = 0; m < 4; ++m) {
                const int row = row0 + ai * 128 + m * 16;
#pragma unroll
                for (int bj = 0; bj < 2; ++bj) {
                    const int col = col0 + bj * 128;
                    f32x4 v0 = acc[ai][bj][m][0], v1 = acc[ai][bj][m][1];
                    if (MODE == 0 || (MODE == 1 && u.pn < 36)) {
                        u32x4 w; w.x = pg8::cvt_pk_bf16(v0[0], v0[1]); w.y = pg8::cvt_pk_bf16(v0[2], v0[3]); w.z = pg8::cvt_pk_bf16(v1[0], v1[1]); w.w = pg8::cvt_pk_bf16(v1[2], v1[3]);
                        *(u32x4*)(O + (size_t)row * ldc + col) = w;
                    } else if (MODE == 1) {
                        if (bj == 0 && wc == 0 && fq < 2) { float* p = F + (size_t)row * 16 + 8 * fq; *(f32x4*)p = v0; *(f32x4*)(p + 4) = v1; }
                    } else if (MODE == 2) {
                        bf16_t* p = O + (size_t)row * ldc + HC_GDN + col; const u32x4 gq = *(const u32x4*)p; float gf[8]; unpack8(gq, gf);
                        u32x4 w; w.x = pg8::cvt_pk_bf16(v0[0] * sigmoidf_(gf[0]), v0[1] * sigmoidf_(gf[1])); w.y = pg8::cvt_pk_bf16(v0[2] * sigmoidf_(gf[2]), v0[3] * sigmoidf_(gf[3]));
                        w.z = pg8::cvt_pk_bf16(v1[0] * sigmoidf_(gf[4]), v1[1] * sigmoidf_(gf[5])); w.w = pg8::cvt_pk_bf16(v1[2] * sigmoidf_(gf[6]), v1[3] * sigmoidf_(gf[7]));
                        *(u32x4*)p = w;
                    } else if (MODE == 3) {
                        bf16_t* p = O + (size_t)row * ldc + HC_GDN + col; const u32x4 mq = *(const u32x4*)p; const u32x4 gq = *(const u32x4*)(O + (size_t)row * ldc + HC_GSB + col);
                        float gf[8], mf[8]; unpack8(gq, gf); unpack8(mq, mf);
                        u32x4 w; w.x = pg8::cvt_pk_bf16(v0[0] * sigmoidf_(gf[0]) + mf[0], v0[1] * sigmoidf_(gf[1]) + mf[1]); w.y = pg8::cvt_pk_bf16(v0[2] * sigmoidf_(gf[2]) + mf[2], v0[3] * sigmoidf_(gf[3]) + mf[3]);
                        w.z = pg8::cvt_pk_bf16(v1[0] * sigmoidf_(gf[4]) + mf[4], v1[1] * sigmoidf_(gf[5]) + mf[5]); w.w = pg8::cvt_pk_bf16(v1[2] * sigmoidf_(gf[6]) + mf[6], v1[3] * sigmoidf_(gf[7]) + mf[7]);
                        *(u32x4*)p = w;
                    } else if (MODE == 4) {
                        const size_t o = (size_t)row * 1024 + col; const f32x4 r0 = *(const f32x4*)(R + o), r1 = *(const f32x4*)(R + o + 4);
                        *(f32x4*)(F + o) = r0 + v0; *(f32x4*)(F + o + 4) = r1 + v1;
                    }
                }
            }
    }
};

__device__ __forceinline__ float wave_sum(float v) {
#pragma unroll
    for (int o = 1; o < 64; o <<= 1) v += __shfl_xor(v, o);
    return v;
}
#define DPPF(v, ctrl) __builtin_bit_cast(float, __builtin_amdgcn_update_dpp(0, __builtin_bit_cast(int, (v)), (ctrl), 0xF, 0xF, false))
__device__ __forceinline__ float row16_sum(float v) {
    v += DPPF(v, 0xB1); v += DPPF(v, 0x4E); v += DPPF(v, 0x124); v += DPPF(v, 0x128); return v;
}

__device__ __forceinline__ void transpose_item(const float* W, int ldw, int K, bf16_t* WT, int k0, int nsrc0, int ndst0, LAS float* scr, int lane) {
#pragma unroll 8
    for (int i = 0; i < 32; ++i) { const int kk = 2 * i + (lane >> 5); scr[kk * 33 + (lane & 31)] = W[(size_t)(k0 + kk) * ldw + nsrc0 + (lane & 31)]; }
    asm volatile("s_waitcnt lgkmcnt(0)" ::: "memory");
    const int c = lane & 7;
#pragma unroll
    for (int j = 0; j < 4; ++j) { const int n = (lane >> 3) + 8 * j; const LAS float* s = scr + (8 * c) * 33 + n;
        u32x4 o; o.x = pk2(s[0 * 33], s[1 * 33]); o.y = pk2(s[2 * 33], s[3 * 33]); o.z = pk2(s[4 * 33], s[5 * 33]); o.w = pk2(s[6 * 33], s[7 * 33]);
        *(u32x4*)(WT + (size_t)(ndst0 + n) * K + k0 + 8 * c) = o; }
    asm volatile("s_waitcnt lgkmcnt(0)" ::: "memory");
}
__device__ __forceinline__ void rms_row_to_bf16(const float* xrow, const float* w, bf16_t* orow, int lane) {
    const f32x4* xr = (const f32x4*)xrow + lane; const f32x4* wr4 = (const f32x4*)w + lane;
    f32x4 v[4]; float s = 0.f;
#pragma unroll
    for (int j = 0; j < 4; ++j) { v[j] = xr[64 * j]; s += (v[j].x * v[j].x + v[j].y * v[j].y) + (v[j].z * v[j].z + v[j].w * v[j].w); }
    const float rstd = 1.f / sqrtf(wave_sum(s) * (1.f / DM) + EPS);
    unsigned long long* o8 = (unsigned long long*)orow + lane;
#pragma unroll
    for (int j = 0; j < 4; ++j) { const f32x4 ww = wr4[64 * j];
        o8[64 * j] = (unsigned long long)pk2(v[j].x * rstd * ww.x, v[j].y * rstd * ww.y) | ((unsigned long long)pk2(v[j].z * rstd * ww.z, v[j].w * rstd * ww.w) << 32); }
}

struct Params {
    const float *x, *norm1_w, *w_in, *dn_conv_w, *dn_A_log, *dn_dt_bias, *dn_norm_w, *w_proj_dn, *w_proj_sb, *w_out, *norm2_w, *ffn_w_up, *ffn_conv_w, *ffn_w_down, *norm_f_w;
    float* out; unsigned char* ws;
};

__device__ __forceinline__ void sb_attn_item(bf16_t* Hg, int item, LAS bf16_t* vs, int lane) {
    const int bh = item >> 7, qt = item & 127, b = bh >> 3, h = bh & 7;
    const int n = lane & 31, hh = lane >> 5, t0 = qt * 32;
    bf16_t* Qp = Hg + (size_t)(b * SEQ) * HW + HC_SBQ + h * 128;
    const bf16_t* Kp = Qp + 1024; const bf16_t* Vp = Qp + 2048;
    bf16x8 qf[8];
#pragma unroll
    for (int c = 0; c < 8; ++c) qf[c] = *(const bf16x8*)(Qp + (size_t)(t0 + n) * HW + c * 16 + hh * 8);
    f32x16 o[4];
#pragma unroll
    for (int e = 0; e < 4; ++e)
#pragma unroll
        for (int r = 0; r < 16; ++r) o[e][r] = 0.f;
    float R = 0.f;
    const float scale = 0.08838834764831845f;
    for (int kt = qt; kt >= 0; --kt) {
        const int s0 = kt * 32;
#pragma unroll
        for (int q = 0; q < 8; ++q) { const int id = lane + 64 * q, row = id >> 4, c16 = id & 15;
            const u32x4 vv = *(const u32x4*)(Vp + (size_t)(s0 + row) * HW + c16 * 8);
            *(LAS u32x4*)(vs + row * 136 + c16 * 8) = vv; }
        f32x16 s;
#pragma unroll
        for (int r = 0; r < 16; ++r) s[r] = 0.f;
#pragma unroll
        for (int c = 0; c < 8; ++c) { const bf16x8 kf = *(const bf16x8*)(Kp + (size_t)(s0 + n) * HW + c * 16 + hh * 8);
            s = __builtin_amdgcn_mfma_f32_32x32x16_bf16(kf, qf[c], s, 0, 0, 0); }
        float lk[16], la[16];
        const int qpos = t0 + n;
#pragma unroll
        for (int r = 0; r < 16; ++r) {
            const int key = s0 + 8 * (r >> 2) + 4 * hh + (r & 3);
            const float z = s[r] * scale;
            const float sp = fmaxf(z, 0.f) + __logf(1.f + __expf(-fabsf(z)));
            const bool valid = key < qpos;
            lk[r] = valid ? -sp : 0.f;
            la[r] = z - sp;
        }
        float G[4], ex[16];
#pragma unroll
        for (int i = 0; i < 4; ++i) { ex[4 * i + 3] = 0.f; ex[4 * i + 2] = lk[4 * i + 3]; ex[4 * i + 1] = ex[4 * i + 2] + lk[4 * i + 2]; ex[4 * i] = ex[4 * i + 1] + lk[4 * i + 1]; G[i] = ex[4 * i] + lk[4 * i]; }
        float P[4];
#pragma unroll
        for (int i = 0; i < 4; ++i) P[i] = __shfl_xor(G[i], 32);
        float L[4]; { float to = 0.f, tp = 0.f;
#pragma unroll
            for (int i = 3; i >= 0; --i) { const float tp_incl = tp + P[i]; L[i] = to + (hh == 0 ? tp_incl : tp); to += G[i]; tp = tp_incl; }
            const float tot = to + tp;
#pragma unroll
            for (int r = 0; r < 16; ++r) { const int key = s0 + 8 * (r >> 2) + 4 * hh + (r & 3); const float la2 = la[r] + R + L[r >> 2] + ex[r]; la[r] = (key < qpos) ? __expf(la2) : 0.f; }
            R += tot; }
        bf16x8 pa[2];
#pragma unroll
        for (int cc = 0; cc < 2; ++cc) { u32x4 w; w.x = pk2(la[8 * cc + 0], la[8 * cc + 1]); w.y = pk2(la[8 * cc + 2], la[8 * cc + 3]); w.z = pk2(la[8 * cc + 4], la[8 * cc + 5]); w.w = pk2(la[8 * cc + 6], la[8 * cc + 7]);
            pa[cc] = __builtin_bit_cast(bf16x8, w); }
        __builtin_amdgcn_fence(__ATOMIC_RELEASE, "wavefront"); __builtin_amdgcn_wave_barrier(); __builtin_amdgcn_fence(__ATOMIC_ACQUIRE, "wavefront");
#pragma unroll
        for (int eb = 0; eb < 4; ++eb)
#pragma unroll
            for (int cc = 0; cc < 2; ++cc) { bf16x8 vf;
#pragma unroll
                for (int jj = 0; jj < 8; ++jj) { const int key = 16 * cc + 8 * (jj >> 2) + 4 * hh + (jj & 3); vf[jj] = (short)vs[key * 136 + eb * 32 + n]; }
                o[eb] = __builtin_amdgcn_mfma_f32_32x32x16_bf16(pa[cc], vf, o[eb], 0, 0, 0); }
        __builtin_amdgcn_fence(__ATOMIC_RELEASE, "wavefront"); __builtin_amdgcn_wave_barrier(); __builtin_amdgcn_fence(__ATOMIC_ACQUIRE, "wavefront");
        if (__all(R < -120.f)) break;
    }
#pragma unroll
    for (int eb = 0; eb < 4; ++eb)
#pragma unroll
        for (int r = 0; r < 16; ++r) { const int row = 8 * (r >> 2) + 4 * hh + (r & 3); Qp[(size_t)(t0 + row) * HW + eb * 32 + n] = (bf16_t)f2bf(o[eb][r]); }
}

__device__ __forceinline__ void dn_scan_item(const bf16_t* __restrict__ DNQ, const float* __restrict__ EG, const float* __restrict__ BETA, bf16_t* __restrict__ Hg, int item, int lane) {
    const int es = item & 31, h = (item >> 5) & 7, b = item >> 8;
    const int dg = lane & 15, e = es * 4 + (lane >> 4), d0 = dg * 8;
    const bf16_t* qp = DNQ + (size_t)(b * SEQ) * 3072 + h * 128 + d0; const bf16_t* kp = qp + 1024;
    const bf16_t* vp = DNQ + (size_t)(b * SEQ) * 3072 + 2048 + h * 128 + e;
    const float* egp = EG + (size_t)(b * SEQ) * 8 + h; const float* bep = BETA + (size_t)(b * SEQ) * 8 + h;
    bf16_t* op = Hg + (size_t)(b * SEQ) * HW + HC_DNQ + h * 128 + e;
    float S[8];
#pragma unroll
    for (int i = 0; i < 8; ++i) S[i] = 0.f;
#pragma unroll 4
    for (int t = 0; t < SEQ; ++t) {
        const u32x4 kq = *(const u32x4*)(kp + (size_t)t * 3072); const u32x4 qq = *(const u32x4*)(qp + (size_t)t * 3072);
        const float v = bf2f(vp[(size_t)t * 3072]); const float eg = egp[t * 8]; const float be = bep[t * 8];
        float k[8], q[8]; unpack8(kq, k); unpack8(qq, q);
        float p = 0.f;
#pragma unroll
        for (int i = 0; i < 8; ++i) { S[i] *= eg; p += k[i] * S[i]; }
        p = row16_sum(p);
        const float vn = be * (v - p);
        float o = 0.f;
#pragma unroll
        for (int i = 0; i < 8; ++i) { S[i] += k[i] * vn; o += q[i] * S[i]; }
        o = row16_sum(o);
        if (dg == 0) op[(size_t)t * HW] = (bf16_t)f2bf(o);
    }
}

__global__ void __launch_bounds__(NTHREADS, 2) fwd_megakernel(Params p) {
    extern __shared__ __attribute__((aligned(16))) unsigned char lds_raw[];
    cg::grid_group grid = cg::this_grid();
    LAS unsigned char* lds = (LAS unsigned char*)lds_raw;
    const int G = gridDim.x, bx = blockIdx.x, NGW = G * NWAVES;
#define PHASE_IDS const int tid = opaque_tid(), lane = tid & 63, wave = __builtin_amdgcn_readfirstlane(tid >> 6), gw = bx * NWAVES + wave; (void)tid; (void)lane; (void)wave; (void)gw
    unsigned char* ws = p.ws;
    bf16_t* WIN = (bf16_t*)(ws + WS_WIN); bf16_t* WPA = (bf16_t*)(ws + WS_WPA); bf16_t* WPB = (bf16_t*)(ws + WS_WPB); bf16_t* WOUT = (bf16_t*)(ws + WS_WOUT);
    bf16_t* WUP = (bf16_t*)(ws + WS_WUP); bf16_t* WDOWN = (bf16_t*)(ws + WS_WDOWN);
    float* AB = (float*)(ws + WS_AB); float* EG = (float*)(ws + WS_EG); float* BETA = (float*)(ws + WS_BETA);
    bf16_t* N1 = (bf16_t*)(ws + WS_N1); bf16_t* H = (bf16_t*)(ws + WS_H); bf16_t* DNQ = (bf16_t*)(ws + WS_DNQ);
    bf16_t* U = (bf16_t*)(ws + WS_U); bf16_t* HACT = (bf16_t*)(ws + WS_HACT);

    {
        PHASE_IDS;
        LAS float* scr = (LAS float*)(lds + wave * 16384);
        constexpr int I_IN = 16 * 289, I_SQ = 16 * 32, I_UP = 16 * 176, I_DN = 44 * 32;
        constexpr int NITEMS = I_IN + 3 * I_SQ + I_UP + I_DN;
        for (int it = gw; it < NITEMS; it += NGW) {
            int r = it;
            if (r < I_IN) { const int kb = r / 289, nb = r % 289, nd = nb * 32; const int nsrc = nd < 3072 ? nd : (nd < 9216 ? nd + 16 : 3072);
                transpose_item(p.w_in, 9232, 1024, WIN, kb * 64, nsrc, nd, scr, lane); continue; } r -= I_IN;
            if (r < I_SQ) { transpose_item(p.w_proj_dn, 1024, 1024, WPA, (r / 32) * 64, (r % 32) * 32, (r % 32) * 32, scr, lane); continue; } r -= I_SQ;
            if (r < I_SQ) { transpose_item(p.w_proj_sb, 1024, 1024, WPB, (r / 32) * 64, (r % 32) * 32, (r % 32) * 32, scr, lane); continue; } r -= I_SQ;
            if (r < I_SQ) { transpose_item(p.w_out, 1024, 1024, WOUT, (r / 32) * 64, (r % 32) * 32, (r % 32) * 32, scr, lane); continue; } r -= I_SQ;
            if (r < I_UP) { transpose_item(p.ffn_w_up, FF2, 1024, WUP, (r / 176) * 64, (r % 176) * 32, (r % 176) * 32, scr, lane); continue; } r -= I_UP;
            transpose_item(p.ffn_w_down, 1024, FF, WDOWN, (r / 32) * 64, (r % 32) * 32, (r % 32) * 32, scr, lane);
        }
        for (int m = gw; m < MTOT; m += NGW) rms_row_to_bf16(p.x + (size_t)m * DM, p.norm1_w, N1 + (size_t)m * DM, lane);
    }
    grid.sync();

    for (int grp = 0; grp < NGRP; ++grp) {
        const size_t row_base = (size_t)grp * MG;
        { pg8::Gemm g{N1 + row_base * DM, WIN, MG, NIN_PAD, DM, DM}; pg8::StaticOrder S; S.init(MG, NIN_PAD, G, bx);
          Epi<1> E{H, HW, AB, nullptr}; pg8::gemm_phase(lds, g, S, E); }
        grid.sync();
        { PHASE_IDS;
        for (int T = gw; T < MG; T += NGW) {
            const int pos = T & (SEQ - 1);
#pragma unroll 1
            for (int it = 0; it < 6; ++it) {
                const int col = (it * 64 + lane) * 8;
                float y[8];
#pragma unroll
                for (int j = 0; j < 8; ++j) y[j] = 0.f;
#pragma unroll
                for (int i = 0; i < 4; ++i) {
                    if (pos - 3 + i >= 0) {
                        const u32x4 xv = *(const u32x4*)(H + (size_t)(T - 3 + i) * HW + col); float xf[8]; unpack8(xv, xf);
                        const f32x4 w0 = *(const f32x4*)(p.dn_conv_w + i * 3072 + col), w1 = *(const f32x4*)(p.dn_conv_w + i * 3072 + col + 4);
                        y[0] += w0.x * xf[0]; y[1] += w0.y * xf[1]; y[2] += w0.z * xf[2]; y[3] += w0.w * xf[3];
                        y[4] += w1.x * xf[4]; y[5] += w1.y * xf[5]; y[6] += w1.z * xf[6]; y[7] += w1.w * xf[7];
                    }
                }
                float ss = 0.f;
#pragma unroll
                for (int j = 0; j < 8; ++j) { y[j] = y[j] / (1.f + __expf(-y[j])); ss += y[j] * y[j]; }
                ss = row16_sum(ss);
                if (col < 2048) { float r = 1.f / sqrtf(ss + EPS); if (col < 1024) r *= 0.08838834764831845f;
#pragma unroll
                    for (int j = 0; j < 8; ++j) y[j] *= r; }
                *(u32x4*)(DNQ + (size_t)T * 3072 + col) = pack8(y);
            }
            if (lane < 8) {
                const float a = AB[(size_t)T * 16 + lane], bb = AB[(size_t)T * 16 + 8 + lane];
                const float xs = a + p.dn_dt_bias[lane];
                const float sp = fmaxf(xs, 0.f) + log1pf(expf(-fabsf(xs)));
                const float gg = -expf(p.dn_A_log[lane]) * sp;
                EG[(size_t)T * 8 + lane] = expf(gg);
                BETA[(size_t)T * 8 + lane] = 1.f / (1.f + expf(-bb));
            }
        } }
        grid.sync();
        { PHASE_IDS;
        if (wave < 4) {
            for (int it = bx * 4 + wave; it < BG * 8 * 32; it += G * 4) dn_scan_item(DNQ, EG, BETA, H, it, lane);
        } else {
            LAS bf16_t* vs = (LAS bf16_t*)(lds + (wave - 4) * 8704);
            for (int it = bx * 4 + (wave - 4); it < BG * 8 * 128; it += G * 4) sb_attn_item(H, it, vs, lane);
        } }
        grid.sync();
        { PHASE_IDS;
        for (int it = gw; it < MG * 2; it += NGW) {
            const int T = it >> 1, h = (it & 1) * 4 + (lane >> 4), e0 = (lane & 15) * 8;
            const u32x4 ov = *(const u32x4*)(H + (size_t)T * HW + HC_DNQ + h * 128 + e0); float of[8]; unpack8(ov, of);
            bf16_t* gp = H + (size_t)T * HW + HC_DNG + h * 128 + e0; const u32x4 gv = *(const u32x4*)gp; float gf[8]; unpack8(gv, gf);
            float ss = 0.f;
#pragma unroll
            for (int j = 0; j < 8; ++j) ss += of[j] * of[j];
            ss = row16_sum(ss);
            const float r = 1.f / sqrtf(ss * (1.f / 128.f) + EPS);
            const f32x4 w0 = *(const f32x4*)(p.dn_norm_w + e0), w1 = *(const f32x4*)(p.dn_norm_w + e0 + 4);
            const float wv[8] = {w0.x, w0.y, w0.z, w0.w, w1.x, w1.y, w1.z, w1.w};
            float y[8];
#pragma unroll
            for (int j = 0; j < 8; ++j) y[j] = of[j] * r * wv[j] * (gf[j] / (1.f + __expf(-gf[j])));
            *(u32x4*)gp = pack8(y);
        } }
        grid.sync();
        { pg8::Gemm g{H + HC_DNG, WPA, MG, DM, DM, HW}; pg8::StaticOrder S; S.init(MG, DM, G, bx); Epi<2> E{H, HW, nullptr, nullptr}; pg8::gemm_phase(lds, g, S, E); }
        { pg8::Gemm g{H + HC_SBQ, WPB, MG, DM, DM, HW}; pg8::StaticOrder S; S.init(MG, DM, G, bx); Epi<3> E{H, HW, nullptr, nullptr}; pg8::gemm_phase(lds, g, S, E); }
        grid.sync();
        { pg8::Gemm g{H + HC_GDN, WOUT, MG, DM, DM, HW}; pg8::StaticOrder S; S.init(MG, DM, G, bx);
          Epi<4> E{nullptr, 0, p.out + row_base * DM, p.x + row_base * DM}; pg8::gemm_phase(lds, g, S, E); }
        grid.sync();
    }
    { PHASE_IDS; for (int m = gw; m < MTOT; m += NGW) rms_row_to_bf16(p.out + (size_t)m * DM, p.norm2_w, N1 + (size_t)m * DM, lane); }
    grid.sync();
    for (int grp = 0; grp < NGRP; ++grp) {
        const size_t row_base = (size_t)grp * MG;
        { pg8::Gemm g{N1 + row_base * DM, WUP, MG, FF2, DM, DM}; pg8::StaticOrder S; S.init(MG, FF2, G, bx); Epi<0> E{U, FF2, nullptr, nullptr}; pg8::gemm_phase(lds, g, S, E); }
        grid.sync();
        { PHASE_IDS;
        for (int it = bx * NTHREADS + tid; it < (MG / 16) * (FF / 8); it += G * NTHREADS) {
            const int cgp = it % (FF / 8), tb = it / (FF / 8), c = cgp * 8, t0 = tb * 16;
            float wg[3][8], wu[3][8];
#pragma unroll
            for (int i = 0; i < 3; ++i) {
                const f32x4 a0 = *(const f32x4*)(p.ffn_conv_w + i * FF2 + c), a1 = *(const f32x4*)(p.ffn_conv_w + i * FF2 + c + 4);
                const f32x4 b0 = *(const f32x4*)(p.ffn_conv_w + i * FF2 + FF + c), b1 = *(const f32x4*)(p.ffn_conv_w + i * FF2 + FF + c + 4);
                wg[i][0] = a0.x; wg[i][1] = a0.y; wg[i][2] = a0.z; wg[i][3] = a0.w; wg[i][4] = a1.x; wg[i][5] = a1.y; wg[i][6] = a1.z; wg[i][7] = a1.w;
                wu[i][0] = b0.x; wu[i][1] = b0.y; wu[i][2] = b0.z; wu[i][3] = b0.w; wu[i][4] = b1.x; wu[i][5] = b1.y; wu[i][6] = b1.z; wu[i][7] = b1.w;
            }
            float g2[8], g1[8], u2[8], u1[8];
            const bool first = (t0 & (SEQ - 1)) == 0;
            if (first) {
#pragma unroll
                for (int j = 0; j < 8; ++j) { g2[j] = g1[j] = u2[j] = u1[j] = 0.f; }
            } else {
                unpack8(*(const u32x4*)(U + (size_t)(t0 - 2) * FF2 + c), g2); unpack8(*(const u32x4*)(U + (size_t)(t0 - 1) * FF2 + c), g1);
                unpack8(*(const u32x4*)(U + (size_t)(t0 - 2) * FF2 + FF + c), u2); unpack8(*(const u32x4*)(U + (size_t)(t0 - 1) * FF2 + FF + c), u1);
            }
#pragma unroll 4
            for (int t = t0; t < t0 + 16; ++t) {
                float g0[8], u0[8]; unpack8(*(const u32x4*)(U + (size_t)t * FF2 + c), g0); unpack8(*(const u32x4*)(U + (size_t)t * FF2 + FF + c), u0);
                float y[8];
#pragma unroll
                for (int j = 0; j < 8; ++j) {
                    const float yg = wg[0][j] * g2[j] + wg[1][j] * g1[j] + wg[2][j] * g0[j];
                    const float yu = wu[0][j] * u2[j] + wu[1][j] * u1[j] + wu[2][j] * u0[j];
                    y[j] = yg / (1.f + __expf(-yg)) * yu;
                    g2[j] = g1[j]; g1[j] = g0[j]; u2[j] = u1[j]; u1[j] = u0[j];
                }
                *(u32x4*)(HACT + (size_t)t * FF + c) = pack8(y);
            }
        } }
        grid.sync();
        { pg8::Gemm g{HACT, WDOWN, MG, DM, FF, FF}; pg8::StaticOrder S; S.init(MG, DM, G, bx);
          Epi<4> E{nullptr, 0, p.out + row_base * DM, p.out + row_base * DM}; pg8::gemm_phase(lds, g, S, E); }
        grid.sync();
    }
    { PHASE_IDS;
    for (int m = gw; m < MTOT; m += NGW) {
        float* row = p.out + (size_t)m * DM;
        f32x4* xr = (f32x4*)row + lane; const f32x4* wr4 = (const f32x4*)p.norm_f_w + lane;
        f32x4 v[4]; float s = 0.f;
#pragma unroll
        for (int j = 0; j < 4; ++j) { v[j] = xr[64 * j]; s += (v[j].x * v[j].x + v[j].y * v[j].y) + (v[j].z * v[j].z + v[j].w * v[j].w); }
        const float rstd = 1.f / sqrtf(wave_sum(s) * (1.f / DM) + EPS);
#pragma unroll
        for (int j = 0; j < 4; ++j) { const f32x4 ww = wr4[64 * j]; xr[64 * j] = v[j] * rstd * ww; }
    } }
}

extern "C" void kernel_launch(void* const* d_in, const int* in_sizes, int n_in, void* d_out, int out_size, void* d_ws, size_t ws_size, hipStream_t stream) {
    static int grid = 0;
    if (grid == 0) {
        if (n_in != 15 || in_sizes[0] != MTOT * DM || out_size != MTOT * DM || ws_size < WS_END) {
            fprintf(stderr, "kernel_launch: unexpected shapes / workspace (n_in %d, ws %zu, need %zu); nothing launched\n", n_in, ws_size, (size_t)WS_END); grid = -1; return; }
        int dev = 0, cus = 0, per_cu = 0;
        hipGetDevice(&dev); hipDeviceGetAttribute(&cus, hipDeviceAttributeMultiprocessorCount, dev);
        if (hipFuncSetAttribute((const void*)fwd_megakernel, hipFuncAttributeMaxDynamicSharedMemorySize, LDS_BYTES) != hipSuccess) { fprintf(stderr, "kernel_launch: hipFuncSetAttribute failed\n"); grid = -1; return; }
        if (hipOccupancyMaxActiveBlocksPerMultiprocessor(&per_cu, (const void*)fwd_megakernel, NTHREADS, LDS_BYTES) != hipSuccess || per_cu < 1) { fprintf(stderr, "kernel_launch: occupancy query gave %d\n", per_cu); per_cu = 1; }
        (void)hipGetLastError();
        grid = cus * per_cu;
    }
    if (grid < 0) return;
    Params p{};
    p.x = (const float*)d_in[0]; p.norm1_w = (const float*)d_in[1]; p.w_in = (const float*)d_in[2]; p.dn_conv_w = (const float*)d_in[3]; p.dn_A_log = (const float*)d_in[4];
    p.dn_dt_bias = (const float*)d_in[5]; p.dn_norm_w = (const float*)d_in[6]; p.w_proj_dn = (const float*)d_in[7]; p.w_proj_sb = (const float*)d_in[8]; p.w_out = (const float*)d_in[9];
    p.norm2_w = (const float*)d_in[10]; p.ffn_w_up = (const float*)d_in[11]; p.ffn_conv_w = (const float*)d_in[12]; p.ffn_w_down = (const float*)d_in[13]; p.norm_f_w = (const float*)d_in[14];
    p.out = (float*)d_out; p.ws = (unsigned char*)d_ws;
    void* args[] = {&p};
    hipError_t e = hipLaunchCooperativeKernel((const void*)fwd_megakernel, dim3(grid), dim3(NTHREADS), args, LDS_BYTES, stream);
    if (e != hipSuccess) fprintf(stderr, "kernel_launch: cooperative launch failed: %s (grid %d)\n", hipGetErrorString(e), grid);
}
```

```cpp
#include <hip/hip_runtime.h>
#include <hip/hip_cooperative_groups.h>
#include <cstdio>
#include <cstdint>
namespace cg = cooperative_groups;

#define LAS __attribute__((address_space(3)))
typedef unsigned short bf16_t;
typedef short bf16x8 __attribute__((ext_vector_type(8)));
typedef float f32x4 __attribute__((ext_vector_type(4)));
typedef float f32x16 __attribute__((ext_vector_type(16)));
typedef unsigned u32x4 __attribute__((ext_vector_type(4)));

constexpr int DM = 1024, SEQ = 4096, NBATCH = 8, MTOT = NBATCH * SEQ;
constexpr int BG = 4, MG = BG * SEQ, NGRP = NBATCH / BG;
constexpr int HW = 9216, NIN_PAD = 9472, FF = 2816, FF2 = 5632;
constexpr int HC_DNQ = 0, HC_DNG = 3072, HC_SBQ = 4096, HC_SBK = 5120, HC_SBV = 6144, HC_GDN = 7168, HC_GSB = 8192;
constexpr float EPS = 1e-6f;
constexpr size_t MiB = 1u << 20;
constexpr size_t WS_WIN = 0, WS_WPA = 19 * MiB, WS_WPB = 21 * MiB, WS_WOUT = 23 * MiB, WS_WUP = 25 * MiB, WS_WDOWN = 36 * MiB;
constexpr size_t WS_AB = 42 * MiB, WS_GL = 43 * MiB, WS_H = 44 * MiB, WS_DNP = 332 * MiB, WS_END = 476 * MiB;
constexpr size_t WS_N2 = 44 * MiB;
constexpr size_t WS_U = 108 * MiB, WS_HACT = 284 * MiB;
constexpr int LDS_BYTES = 147456;
constexpr int NTHREADS = 512, NWAVES = 8;

__device__ __forceinline__ unsigned f2bf(float f) { unsigned u = __builtin_bit_cast(unsigned, f); return (u + 0x7fffu + ((u >> 16) & 1u)) >> 16; }
__device__ __forceinline__ unsigned pk2(float lo, float hi) { return f2bf(lo) | (f2bf(hi) << 16); }
__device__ __forceinline__ float bflo(unsigned u) { return __builtin_bit_cast(float, u << 16); }
__device__ __forceinline__ float bfhi(unsigned u) { return __builtin_bit_cast(float, u & 0xffff0000u); }
__device__ __forceinline__ float bf2f(unsigned short h) { return __builtin_bit_cast(float, (unsigned)h << 16); }
__device__ __forceinline__ float sigmoidf_(float x) { return 1.f / (1.f + __expf(-x)); }
__device__ __forceinline__ void unpack8(u32x4 u, float* f) {
    f[0] = bflo(u.x); f[1] = bfhi(u.x); f[2] = bflo(u.y); f[3] = bfhi(u.y); f[4] = bflo(u.z); f[5] = bfhi(u.z); f[6] = bflo(u.w); f[7] = bfhi(u.w);
}
__device__ __forceinline__ u32x4 pack8(const float* f) { u32x4 o; o.x = pk2(f[0], f[1]); o.y = pk2(f[2], f[3]); o.z = pk2(f[4], f[5]); o.w = pk2(f[6], f[7]); return o; }

__device__ __forceinline__ int opaque_tid() { int t = threadIdx.x; asm volatile("" : "+v"(t)); return t; }

namespace pg8 {
constexpr int BM = 256, BK = 64, HALF = 128, HTB = HALF * BK * 2, NXCD = 8, WGM = 8;
__host__ __device__ __forceinline__ int lds_byte(int r, int c) { const int st = (r >> 4) * 2 + (c >> 5), rr = r & 15, cc = c & 31, ob = rr * 64 + cc * 2; return st * 1024 + (ob ^ (((ob >> 9) & 1) << 5)); }
__host__ __device__ __forceinline__ void stage_rc(int b, int& R, int& C) { const int st = b / 1024, sb = b % 1024, swz = sb ^ (((sb >> 9) & 1) << 5); R = (st >> 1) * 16 + swz / 64; C = (st & 1) * 32 + (swz % 64) / 2; }
__host__ __device__ __forceinline__ int perm32(int rho) { const int n = rho >> 4, i = rho & 15; return 8 * (i >> 2) + 4 * n + (i & 3); }
struct Unit { int pm, pn; };
struct Gemm { const bf16_t* A; const bf16_t* Bt; int M, N, K, lda; };
struct StaticOrder {
    int nM, nN, nwg, G, c;
    __device__ void init(int M, int N, int G_, int c_) { nM = M / BM; nN = N / BM; nwg = nM * nN; G = G_; c = c_; }
    __device__ bool next(int i, Unit& u) const {
        const long L = (long)i * G + c; if (L >= nwg) return false;
        int wgid = (int)L; { const int q = nwg / NXCD, r = nwg % NXCD, xcd = wgid % NXCD, off = wgid / NXCD; wgid = (xcd < r ? xcd * (q + 1) : r * (q + 1) + (xcd - r) * q) + off; }
        const int nig = WGM * nN, gid = wgid / nig, fm = gid * WGM, gsz = (nM - fm) < WGM ? (nM - fm) : WGM;
        u.pm = fm + ((wgid % nig) % gsz); u.pn = (wgid % nig) / gsz; return true;
    }
};
__device__ __forceinline__ unsigned cvt_pk_bf16(float lo, float hi) { unsigned r; asm volatile("v_cvt_pk_bf16_f32 %0, %1, %2" : "=v"(r) : "v"(lo), "v"(hi)); return r; }

template <class Epi>
__device__ __forceinline__ void gemm_phase(LAS unsigned char* lds, const Gemm g, const StaticOrder& S, const Epi& E) {
    const int tid = opaque_tid(), wid = __builtin_amdgcn_readfirstlane(tid >> 6), lane = tid & 63, wr = wid >> 2, wc = wid & 3, fr = lane & 15, fq = lane >> 4;
    const int K = g.K, nt = K / BK, lda = g.lda;
    unsigned voffA[2], voffB[2];
#pragma unroll
    for (int i = 0; i < 2; ++i) { int R, C; stage_rc(tid * 16 + i * 8192, R, C); const int Rb = (R & ~31) + perm32(R & 31);
        voffA[i] = (unsigned)(R * lda + C) * 2u; voffB[i] = (unsigned)(Rb * K + C) * 2u; }
    const size_t kstep = (size_t)(BK * 2);
    const size_t hstepA = (size_t)HALF * lda * 2, hstepB = (size_t)HALF * K * 2;
    const size_t tstepA = 2 * hstepA, tstepB = 2 * hstepB;
    const unsigned ldsw = (unsigned)wid * 1024u;
    const int aoff = lds_byte(wr * 64 + fr, fq * 8), boff = lds_byte(wc * 32 + fr, fq * 8);
#define PG8_SA(b, h) (((b) * 2 + (h)) * HTB)
#define PG8_SB(b, h) ((4 + (b) * 2 + (h)) * HTB)
#define PG8_STAGE(bufoff, gbase, voff) do { _Pragma("unroll") for (int _i = 0; _i < 2; ++_i) \
        __builtin_amdgcn_global_load_lds((const unsigned*)((const char*)(gbase) + (voff)[_i]), (LAS unsigned*)(lds + (bufoff) + ldsw + _i * 8192), 16, 0, 0); } while (0)
#define PG8_LDA(dst, b, h) do { _Pragma("unroll") for (int m = 0; m < 4; ++m) _Pragma("unroll") for (int k = 0; k < 2; ++k) dst[m][k] = *(const LAS bf16x8*)(lds + PG8_SA(b, h) + aoff + m * 2048 + k * 1024); } while (0)
#define PG8_LDB(dst, b, h) do { _Pragma("unroll") for (int n = 0; n < 2; ++n) _Pragma("unroll") for (int k = 0; k < 2; ++k) dst[n][k] = *(const LAS bf16x8*)(lds + PG8_SB(b, h) + boff + n * 2048 + k * 1024); } while (0)
#define PG8_MMA(ai, bj, At, Bt) do { __builtin_amdgcn_s_setprio(1); _Pragma("unroll") for (int m = 0; m < 4; ++m) _Pragma("unroll") for (int n = 0; n < 2; ++n) _Pragma("unroll") for (int k = 0; k < 2; ++k) \
        acc[ai][bj][m][n] = __builtin_amdgcn_mfma_f32_16x16x32_bf16(Bt[n][k], At[m][k], acc[ai][bj][m][n], 0, 0, 0); __builtin_amdgcn_s_setprio(0); } while (0)
#define PG8_WAIT_V(n) asm volatile("s_waitcnt vmcnt(" #n ")" ::: "memory")
#define PG8_WAIT_L(n) asm volatile("s_waitcnt lgkmcnt(" #n ")" ::: "memory")
#define PG8_BAR __builtin_amdgcn_s_barrier()
#define PG8_SCHED __builtin_amdgcn_sched_barrier(0)
    Unit cur, nxt; int ui = 0;
    if (!S.next(0, cur)) return;
    f32x4 acc[2][2][4][2];
#pragma unroll
    for (int a = 0; a < 2; ++a)
#pragma unroll
        for (int b = 0; b < 2; ++b)
#pragma unroll
            for (int m = 0; m < 4; ++m)
#pragma unroll
                for (int n = 0; n < 2; ++n) acc[a][b][m][n] = (f32x4){0.f, 0.f, 0.f, 0.f};
    bf16x8 At[4][2], B0[2][2], B1[2][2];
    const char* cA = (const char*)g.A + (size_t)cur.pm * tstepA; const char* cB = (const char*)g.Bt + (size_t)cur.pn * tstepB;
    PG8_STAGE(PG8_SB(0, 0), cB, voffB); PG8_STAGE(PG8_SB(0, 1), cB + hstepB, voffB); PG8_STAGE(PG8_SA(0, 0), cA, voffA); PG8_STAGE(PG8_SA(0, 1), cA + hstepA, voffA);
    if (wr == 1) PG8_BAR;
    PG8_WAIT_V(2); PG8_BAR;
    PG8_STAGE(PG8_SB(1, 0), cB + kstep, voffB); PG8_STAGE(PG8_SA(1, 0), cA + kstep, voffA); PG8_STAGE(PG8_SB(1, 1), cB + hstepB + kstep, voffB);
    PG8_WAIT_V(6); PG8_BAR;
    for (;;) {
        const bool has_next = S.next(ui + 1, nxt);
        const char* nA = has_next ? (const char*)g.A + (size_t)nxt.pm * tstepA : cA; const char* nB = has_next ? (const char*)g.Bt + (size_t)nxt.pn * tstepB : cB;
        for (int t = 0; t < nt; t += 2) {
            const bool last = (t == nt - 2);
            const char* a1 = cA + (size_t)(t + 1) * kstep;
            const char* a2 = last ? nA : cA + (size_t)(t + 2) * kstep; const char* b2 = last ? nB : cB + (size_t)(t + 2) * kstep;
            const char* a3 = a2 + kstep; const char* b3 = b2 + kstep;
            PG8_LDB(B0, 0, 0); PG8_LDB(B1, 0, 1); PG8_SCHED; PG8_LDA(At, 0, 0); PG8_STAGE(PG8_SA(1, 1), a1 + hstepA, voffA);
            PG8_WAIT_V(8); PG8_WAIT_L(0); PG8_BAR; PG8_MMA(0, 0, At, B0); PG8_MMA(0, 1, At, B1); PG8_BAR; PG8_SCHED;
            PG8_LDA(At, 0, 1); PG8_STAGE(PG8_SB(0, 0), b2, voffB); PG8_STAGE(PG8_SB(0, 1), b2 + hstepB, voffB); PG8_STAGE(PG8_SA(0, 0), a2, voffA);
            PG8_WAIT_V(8); PG8_WAIT_L(0); PG8_BAR; PG8_MMA(1, 0, At, B0); PG8_MMA(1, 1, At, B1); PG8_BAR; PG8_SCHED;
            PG8_LDB(B0, 1, 0); PG8_LDB(B1, 1, 1); PG8_SCHED; PG8_LDA(At, 1, 0); PG8_STAGE(PG8_SA(0, 1), a2 + hstepA, voffA);
            PG8_WAIT_V(8); PG8_WAIT_L(0); PG8_BAR; PG8_MMA(0, 0, At, B0); PG8_MMA(0, 1, At, B1); PG8_BAR; PG8_SCHED;
            PG8_LDA(At, 1, 1); PG8_STAGE(PG8_SB(1, 0), b3, voffB); PG8_STAGE(PG8_SB(1, 1), b3 + hstepB, voffB); PG8_STAGE(PG8_SA(1, 0), a3, voffA);
            PG8_WAIT_V(8); PG8_WAIT_L(0); PG8_BAR; PG8_MMA(1, 0, At, B0); PG8_MMA(1, 1, At, B1); PG8_BAR; PG8_SCHED;
        }
        if (wr == 0) PG8_BAR;
        E(acc, cur, wr, wc, fr, fq);
        if (!has_next) break;
#pragma unroll
        for (int a = 0; a < 2; ++a)
#pragma unroll
            for (int b = 0; b < 2; ++b)
#pragma unroll
                for (int m = 0; m < 4; ++m)
#pragma unroll
                    for (int n = 0; n < 2; ++n) acc[a][b][m][n] = (f32x4){0.f, 0.f, 0.f, 0.f};
        cur = nxt; cA = nA; cB = nB; ++ui;
        if (wr == 1) PG8_BAR;
    }
    PG8_WAIT_V(0);
    PG8_BAR;
#undef PG8_SA
#undef PG8_SB
#undef PG8_STAGE
#undef PG8_LDA
#undef PG8_LDB
#undef PG8_MMA
#undef PG8_WAIT_V
#undef PG8_WAIT_L
#undef PG8_BAR
#undef PG8_SCHED
}
}

template <int MODE> struct Epi {
    bf16_t* O; int ldc; float* F; const float* R;
    __device__ __forceinline__ void operator()(const f32x4 (&acc)[2][2][4][2], const pg8::Unit& u, int wr, int wc, int fr, int fq) const {
        const int row0 = u.pm * 256 + wr * 64 + fr; const int col0 = u.pn * 256 + wc * 32 + 8 * fq;
#pragma unroll
        for (int ai = 0; ai < 2; ++ai)
#pragma unroll
            for (int m = 0; m < 4; ++m) {
                const int row = row0 + ai * 128 + m * 16;
#pragma unroll
                for (int bj = 0; bj < 2; ++bj) {
                    const int col = col0 + bj * 128;
                    f32x4 v0 = acc[ai][bj][m][0], v1 = acc[ai][bj][m][1];
                    if (MODE == 0 || (MODE == 1 && u.pn < 36)) {
                        u32x4 w; w.x = pg8::cvt_pk_bf16(v0[0], v0[1]); w.y = pg8::cvt_pk_bf16(v0[2], v0[3]); w.z = pg8::cvt_pk_bf16(v1[0], v1[1]); w.w = pg8::cvt_pk_bf16(v1[2], v1[3]);
                        *(u32x4*)(O + (size_t)row * ldc + col) = w;
                    } else if (MODE == 1) {
                        if (bj == 0 && wc == 0 && fq < 2) { float* p = F + (size_t)row * 16 + 8 * fq; *(f32x4*)p = v0; *(f32x4*)(p + 4) = v1; }
                    } else if (MODE == 2) {
                        bf16_t* p = O + (size_t)row * ldc + HC_GDN + col; const u32x4 gq = *(const u32x4*)p; float gf[8]; unpack8(gq, gf);
                        u32x4 w; w.x = pg8::cvt_pk_bf16(v0[0] * sigmoidf_(gf[0]), v0[1] * sigmoidf_(gf[1])); w.y = pg8::cvt_pk_bf16(v0[2] * sigmoidf_(gf[2]), v0[3] * sigmoidf_(gf[3]));
                        w.z = pg8::cvt_pk_bf16(v1[0] * sigmoidf_(gf[4]), v1[1] * sigmoidf_(gf[5])); w.w = pg8::cvt_pk_bf16(v1[2] * sigmoidf_(gf[6]), v1[3] * sigmoidf_(gf[7]));
                        *(u32x4*)p = w;
                    } else if (MODE == 3) {
                        bf16_t* p = O + (size_t)row * ldc + HC_GDN + col; const u32x4 mq = *(const u32x4*)p; const u32x4 gq = *(const u32x4*)(O + (size_t)row * ldc + HC_GSB + col);
                        float gf[8], mf[8]; unpack8(gq, gf); unpack8(mq, mf);
                        u32x4 w; w.x = pg8::cvt_pk_bf16(v0[0] * sigmoidf_(gf[0]) + mf[0], v0[1] * sigmoidf_(gf[1]) + mf[1]); w.y = pg8::cvt_pk_bf16(v0[2] * sigmoidf_(gf[2]) + mf[2], v0[3] * sigmoidf_(gf[3]) + mf[3]);
                        w.z = pg8::cvt_pk_bf16(v1[0] * sigmoidf_(gf[4]) + mf[4], v1[1] * sigmoidf_(gf[5]) + mf[5]); w.w = pg8::cvt_pk_bf16(v1[2] * sigmoidf_(gf[6]) + mf[6], v1[3] * sigmoidf_(gf[7]) + mf[7]);
                        *(u32x4*)p = w;
                    } else if (MODE == 4) {
                        const size_t o = (size_t)row * 1024 + col; const f32x4 r0 = *(const f32x4*)(R + o), r1 = *(const f32x4*)(R + o + 4);
                        *(f32x4*)(F + o) = r0 + v0; *(f32x4*)(F + o + 4) = r1 + v1;
                    }
                }
            }
    }
};

__device__ __forceinline__ float wave_sum(float v) {
#pragma unroll
    for (int o = 1; o < 64; o <<= 1) v += __shfl_xor(v, o);
    return v;
}
#define DPPF(v, ctrl) __builtin_bit_cast(float, __builtin_amdgcn_update_dpp(0, __builtin_bit_cast(int, (v)), (ctrl), 0xF, 0xF, false))
__device__ __forceinline__ float row16_sum(float v) {
    v += DPPF(v, 0xB1); v += DPPF(v, 0x4E); v += DPPF(v, 0x124); v += DPPF(v, 0x128); return v;
}

__device__ __forceinline__ void transpose_item(const float* W, int ldw, int K, bf16_t* WT, int k0, int nsrc0, int ndst0, LAS float* scr, int lane) {
#pragma unroll 8
    for (int i = 0; i < 32; ++i) { const int kk = 2 * i + (lane >> 5); scr[kk * 33 + (lane & 31)] = W[(size_t)(k0 + kk) * ldw + nsrc0 + (lane & 31)]; }
    asm volatile("s_waitcnt lgkmcnt(0)" ::: "memory");
    const int c = lane & 7;
#pragma unroll
    for (int j = 0; j < 4; ++j) { const int n = (lane >> 3) + 8 * j; const LAS float* s = scr + (8 * c) * 33 + n;
        u32x4 o; o.x = pk2(s[0 * 33], s[1 * 33]); o.y = pk2(s[2 * 33], s[3 * 33]); o.z = pk2(s[4 * 33], s[5 * 33]); o.w = pk2(s[6 * 33], s[7 * 33]);
        *(u32x4*)(WT + (size_t)(ndst0 + n) * K + k0 + 8 * c) = o; }
    asm volatile("s_waitcnt lgkmcnt(0)" ::: "memory");
}
__device__ __forceinline__ void rms_row_to_bf16(const float* xrow, const float* w, bf16_t* orow, int lane) {
    const f32x4* xr = (const f32x4*)xrow + lane; const f32x4* wr4 = (const f32x4*)w + lane;
    f32x4 v[4]; float s = 0.f;
#pragma unroll
    for (int j = 0; j < 4; ++j) { v[j] = xr[64 * j]; s += (v[j].x * v[j].x + v[j].y * v[j].y) + (v[j].z * v[j].z + v[j].w * v[j].w); }
    const float rstd = 1.f / sqrtf(wave_sum(s) * (1.f / DM) + EPS);
    unsigned long long* o8 = (unsigned long long*)orow + lane;
#pragma unroll
    for (int j = 0; j < 4; ++j) { const f32x4 ww = wr4[64 * j];
        o8[64 * j] = (unsigned long long)pk2(v[j].x * rstd * ww.x, v[j].y * rstd * ww.y) | ((unsigned long long)pk2(v[j].z * rstd * ww.z, v[j].w * rstd * ww.w) << 32); }
}

struct Params {
    const float *x, *norm1_w, *w_in, *dn_conv_w, *dn_A_log, *dn_dt_bias, *dn_norm_w, *w_proj_dn, *w_proj_sb, *w_out, *norm2_w, *ffn_w_up, *ffn_conv_w, *ffn_w_down, *norm_f_w;
    float* out; unsigned char* ws;
};

__device__ __forceinline__ void sb_attn_item(bf16_t* Hg, int item, LAS bf16_t* vs, int lane) {
    const int bh = item >> 7, qt = item & 127, b = bh >> 3, h = bh & 7;
    const int n = lane & 31, hh = lane >> 5, t0 = qt * 32;
    bf16_t* Qp = Hg + (size_t)(b * SEQ) * HW + HC_SBQ + h * 128;
    const bf16_t* Kp = Qp + 1024; const bf16_t* Vp = Qp + 2048;
    bf16x8 qf[8];
#pragma unroll
    for (int c = 0; c < 8; ++c) qf[c] = *(const bf16x8*)(Qp + (size_t)(t0 + n) * HW + c * 16 + hh * 8);
    f32x16 o[4];
#pragma unroll
    for (int e = 0; e < 4; ++e)
#pragma unroll
        for (int r = 0; r < 16; ++r) o[e][r] = 0.f;
    float R = 0.f;
    const float scale = 0.08838834764831845f;
    for (int kt = qt; kt >= 0; --kt) {
        const int s0 = kt * 32;
#pragma unroll
        for (int q = 0; q < 8; ++q) { const int id = lane + 64 * q, row = id >> 4, c16 = id & 15;
            const u32x4 vv = *(const u32x4*)(Vp + (size_t)(s0 + row) * HW + c16 * 8);
            *(LAS u32x4*)(vs + row * 136 + c16 * 8) = vv; }
        f32x16 s;
#pragma unroll
        for (int r = 0; r < 16; ++r) s[r] = 0.f;
#pragma unroll
        for (int c = 0; c < 8; ++c) { const bf16x8 kf = *(const bf16x8*)(Kp + (size_t)(s0 + n) * HW + c * 16 + hh * 8);
            s = __builtin_amdgcn_mfma_f32_32x32x16_bf16(kf, qf[c], s, 0, 0, 0); }
        float lk[16], la[16];
        const int qpos = t0 + n;
#pragma unroll
        for (int r = 0; r < 16; ++r) {
            const int key = s0 + 8 * (r >> 2) + 4 * hh + (r & 3);
            const float z = s[r] * scale;
            const float sp = fmaxf(z, 0.f) + __logf(1.f + __expf(-fabsf(z)));
            const bool valid = key < qpos;
            lk[r] = valid ? -sp : 0.f;
            la[r] = z - sp;
        }
        float G[4], ex[16];
#pragma unroll
        for (int i = 0; i < 4; ++i) { ex[4 * i + 3] = 0.f; ex[4 * i + 2] = lk[4 * i + 3]; ex[4 * i + 1] = ex[4 * i + 2] + lk[4 * i + 2]; ex[4 * i] = ex[4 * i + 1] + lk[4 * i + 1]; G[i] = ex[4 * i] + lk[4 * i]; }
        float P[4];
#pragma unroll
        for (int i = 0; i < 4; ++i) P[i] = __shfl_xor(G[i], 32);
        float L[4]; { float to = 0.f, tp = 0.f;
#pragma unroll
            for (int i = 3; i >= 0; --i) { const float tp_incl = tp + P[i]; L[i] = to + (hh == 0 ? tp_incl : tp); to += G[i]; tp = tp_incl; }
            const float tot = to + tp;
#pragma unroll
            for (int r = 0; r < 16; ++r) { const int key = s0 + 8 * (r >> 2) + 4 * hh + (r & 3); const float la2 = la[r] + R + L[r >> 2] + ex[r]; la[r] = (key < qpos) ? __expf(la2) : 0.f; }
            R += tot; }
        bf16x8 pa[2];
#pragma unroll
        for (int cc = 0; cc < 2; ++cc) { u32x4 w; w.x = pk2(la[8 * cc + 0], la[8 * cc + 1]); w.y = pk2(la[8 * cc + 2], la[8 * cc + 3]); w.z = pk2(la[8 * cc + 4], la[8 * cc + 5]); w.w = pk2(la[8 * cc + 6], la[8 * cc + 7]);
            pa[cc] = __builtin_bit_cast(bf16x8, w); }
        __builtin_amdgcn_fence(__ATOMIC_RELEASE, "wavefront"); __builtin_amdgcn_wave_barrier(); __builtin_amdgcn_fence(__ATOMIC_ACQUIRE, "wavefront");
#pragma unroll
        for (int eb = 0; eb < 4; ++eb)
#pragma unroll
            for (int cc = 0; cc < 2; ++cc) { bf16x8 vf;
#pragma unroll
                for (int jj = 0; jj < 8; ++jj) { const int key = 16 * cc + 8 * (jj >> 2) + 4 * hh + (jj & 3); vf[jj] = (short)vs[key * 136 + eb * 32 + n]; }
                o[eb] = __builtin_amdgcn_mfma_f32_32x32x16_bf16(pa[cc], vf, o[eb], 0, 0, 0); }
        __builtin_amdgcn_fence(__ATOMIC_RELEASE, "wavefront"); __builtin_amdgcn_wave_barrier(); __builtin_amdgcn_fence(__ATOMIC_ACQUIRE, "wavefront");
        if (__all(R < -120.f)) break;
    }
#pragma unroll
    for (int eb = 0; eb < 4; ++eb)
#pragma unroll
        for (int r = 0; r < 16; ++r) { const int row = 8 * (r >> 2) + 4 * hh + (r & 3); Qp[(size_t)(t0 + row) * HW + eb * 32 + n] = (bf16_t)f2bf(o[eb][r]); }
}

constexpr int DNP_CHUNK = 73728, DNP_W = 0, DNP_QG = 16384, DNP_KGT = 32768, DNP_AQK = 49152, DNP_U = 57344;
__device__ __forceinline__ int frag_off(int row, int x, int nks) {
    const int mb = row >> 5, r = row & 31, st = x >> 4, q = (x >> 2) & 3, hh = q & 1, jj = ((q >> 1) << 2) | (x & 3);
    return ((mb * nks + st) * 64 + hh * 32 + r) * 8 + jj;
}
__device__ __forceinline__ bf16x8 cvt8(const f32x16& v, int half) {
    u32x4 w; w.x = pk2(v[8 * half + 0], v[8 * half + 1]); w.y = pk2(v[8 * half + 2], v[8 * half + 3]); w.z = pk2(v[8 * half + 4], v[8 * half + 5]); w.w = pk2(v[8 * half + 6], v[8 * half + 7]);
    return __builtin_bit_cast(bf16x8, w);
}
__device__ __forceinline__ void dn_chunk_scan_item(const unsigned char* __restrict__ DNP, const float* __restrict__ GL, bf16_t* __restrict__ Hg, int item, int lane) {
    const int eb = item & 3, h = (item >> 2) & 7, b = item >> 5;
    const int n = lane & 31, hh = lane >> 5;
    f32x16 S[4];
#pragma unroll
    for (int d = 0; d < 4; ++d)
#pragma unroll
        for (int r = 0; r < 16; ++r) S[d][r] = 0.f;
    for (int ch = 0; ch < 64; ++ch) {
        const int cidx = (b * 8 + h) * 64 + ch;
        const unsigned char* cp = DNP + (size_t)cidx * DNP_CHUNK;
        const bf16x8* Wf = (const bf16x8*)(cp + DNP_W) + lane; const bf16x8* QGf = (const bf16x8*)(cp + DNP_QG) + lane;
        const bf16x8* KGTf = (const bf16x8*)(cp + DNP_KGT) + lane; const bf16x8* AQKf = (const bf16x8*)(cp + DNP_AQK) + lane;
        const bf16_t* Uf = (const bf16_t*)(cp + DNP_U);
        const float egl = GL[cidx];
        bf16x8 sb[8];
#pragma unroll
        for (int ks = 0; ks < 8; ++ks) sb[ks] = cvt8(S[ks >> 1], ks & 1);
        f32x16 vn[2], o[2];
#pragma unroll
        for (int mb = 0; mb < 2; ++mb) {
            f32x16 acc;
#pragma unroll
            for (int r = 0; r < 16; ++r) { acc[r] = 0.f; o[mb][r] = 0.f; }
#pragma unroll
            for (int ks = 0; ks < 8; ++ks) acc = __builtin_amdgcn_mfma_f32_32x32x16_bf16(Wf[(mb * 8 + ks) * 64], sb[ks], acc, 0, 0, 0);
            const u32x4* up = (const u32x4*)(Uf + ((((eb * 2 + mb) * 2 + hh) * 32 + n) * 16));
            const u32x4 u0 = up[0], u1 = up[1]; float uf[16]; unpack8(u0, uf); unpack8(u1, uf + 8);
#pragma unroll
            for (int r = 0; r < 16; ++r) vn[mb][r] = uf[r] - acc[r];
#pragma unroll
            for (int ks = 0; ks < 8; ++ks) o[mb] = __builtin_amdgcn_mfma_f32_32x32x16_bf16(QGf[(mb * 8 + ks) * 64], sb[ks], o[mb], 0, 0, 0);
        }
        bf16x8 vb[4];
#pragma unroll
        for (int cs = 0; cs < 4; ++cs) vb[cs] = cvt8(vn[cs >> 1], cs & 1);
#pragma unroll
        for (int mb = 0; mb < 2; ++mb)
#pragma unroll
            for (int cs = 0; cs < 4; ++cs) o[mb] = __builtin_amdgcn_mfma_f32_32x32x16_bf16(AQKf[(mb * 4 + cs) * 64], vb[cs], o[mb], 0, 0, 0);
#pragma unroll
        for (int db = 0; db < 4; ++db) {
#pragma unroll
            for (int r = 0; r < 16; ++r) S[db][r] *= egl;
#pragma unroll
            for (int cs = 0; cs < 4; ++cs) S[db] = __builtin_amdgcn_mfma_f32_32x32x16_bf16(KGTf[(db * 4 + cs) * 64], vb[cs], S[db], 0, 0, 0);
        }
        bf16_t* op = Hg + (size_t)(b * SEQ + ch * 64) * HW + HC_DNQ + h * 128 + eb * 32 + n;
#pragma unroll
        for (int mb = 0; mb < 2; ++mb)
#pragma unroll
            for (int r = 0; r < 16; ++r) { const int c = 32 * mb + 8 * (r >> 2) + 4 * hh + (r & 3); op[(size_t)c * HW] = (bf16_t)f2bf(o[mb][r]); }
    }
}

__device__ __forceinline__ void dn_prep_chunk(const Params& p, const bf16_t* __restrict__ Hg, const float* __restrict__ AB, unsigned char* __restrict__ DNP, float* __restrict__ GL, int cidx, LAS unsigned char* lds, int tid) {
    const int lane = tid & 63, wave = __builtin_amdgcn_readfirstlane(tid >> 6);
    const int nch = cidx & 63, h = (cidx >> 6) & 7, b = cidx >> 9;
    const int Tc = b * SEQ + nch * 64;
    LAS bf16_t* qs = (LAS bf16_t*)lds; LAS bf16_t* ks = qs + 64 * 136; LAS bf16_t* vs = ks + 64 * 136;
    LAS float* LT = (LAS float*)(lds + 3 * 64 * 136 * 2); LAS float* gcs = LT + 64 * 68; LAS float* betas = gcs + 64;
    unsigned char* cp = DNP + (size_t)cidx * DNP_CHUNK;
#pragma unroll 1
    for (int it = 0; it < 6; ++it) {
        const int item = tid + 512 * it, tok = item / 48, cgp = item - tok * 48, seg = cgp >> 4, c8 = (cgp & 15) * 8;
        const int col = seg * 1024 + h * 128 + c8, pos = nch * 64 + tok;
        float y[8];
#pragma unroll
        for (int j = 0; j < 8; ++j) y[j] = 0.f;
#pragma unroll
        for (int i = 0; i < 4; ++i) {
            if (pos - 3 + i >= 0) {
                const u32x4 xv = *(const u32x4*)(Hg + (size_t)(Tc + tok - 3 + i) * HW + col); float xf[8]; unpack8(xv, xf);
                const f32x4 w0 = *(const f32x4*)(p.dn_conv_w + i * 3072 + col), w1 = *(const f32x4*)(p.dn_conv_w + i * 3072 + col + 4);
                y[0] += w0.x * xf[0]; y[1] += w0.y * xf[1]; y[2] += w0.z * xf[2]; y[3] += w0.w * xf[3];
                y[4] += w1.x * xf[4]; y[5] += w1.y * xf[5]; y[6] += w1.z * xf[6]; y[7] += w1.w * xf[7];
            }
        }
        float ss = 0.f;
#pragma unroll
        for (int j = 0; j < 8; ++j) { y[j] = y[j] / (1.f + __expf(-y[j])); ss += y[j] * y[j]; }
        ss = row16_sum(ss);
        if (seg < 2) { float r = 1.f / sqrtf(ss + EPS); if (seg == 0) r *= 0.08838834764831845f;
#pragma unroll
            for (int j = 0; j < 8; ++j) y[j] *= r; }
        LAS bf16_t* dst = (seg == 0 ? qs : (seg == 1 ? ks : vs)) + tok * 136 + c8;
        *(LAS u32x4*)dst = pack8(y);
    }
    if (wave == 0) {
        const float a = AB[(size_t)(Tc + lane) * 16 + h], bb = AB[(size_t)(Tc + lane) * 16 + 8 + h];
        const float xs = a + p.dn_dt_bias[h];
        const float sp = fmaxf(xs, 0.f) + log1pf(expf(-fabsf(xs)));
        float g = -expf(p.dn_A_log[h]) * sp;
#pragma unroll
        for (int off = 1; off < 64; off <<= 1) { const float t = __shfl_up(g, off); if (lane >= off) g += t; }
        gcs[lane] = g; betas[lane] = 1.f / (1.f + expf(-bb));
        if (lane == 63) GL[cidx] = expf(g);
    }
    __syncthreads();
    {
        const int which = wave >> 2, mb = (wave >> 1) & 1, nb = wave & 1, n = lane & 31, hh = lane >> 5;
        const LAS bf16_t* Asrc = which ? qs : ks;
        f32x16 acc;
#pragma unroll
        for (int r = 0; r < 16; ++r) acc[r] = 0.f;
#pragma unroll
        for (int kk = 0; kk < 8; ++kk) {
            const bf16x8 af = *(const LAS bf16x8*)(Asrc + (mb * 32 + n) * 136 + kk * 16 + hh * 8);
            const bf16x8 bfr = *(const LAS bf16x8*)(ks + (nb * 32 + n) * 136 + kk * 16 + hh * 8);
            acc = __builtin_amdgcn_mfma_f32_32x32x16_bf16(af, bfr, acc, 0, 0, 0);
        }
        const int s = nb * 32 + n; const float gs = gcs[s];
        if (which == 0) {
#pragma unroll
            for (int i = 0; i < 4; ++i) { f32x4 o4;
#pragma unroll
                for (int j = 0; j < 4; ++j) { const int c = mb * 32 + 8 * i + 4 * hh + j; o4[j] = (c > s) ? betas[c] * acc[4 * i + j] * __expf(gcs[c] - gs) : 0.f; }
                *(LAS f32x4*)(LT + s * 68 + mb * 32 + 8 * i + 4 * hh) = o4; }
        } else {
            bf16_t* aq = (bf16_t*)(cp + DNP_AQK);
#pragma unroll
            for (int r = 0; r < 16; ++r) { const int c = mb * 32 + 8 * (r >> 2) + 4 * hh + (r & 3); const float v = (c >= s) ? acc[r] * __expf(gcs[c] - gs) : 0.f; aq[frag_off(c, s, 4)] = (bf16_t)f2bf(v); }
        }
    }
    __syncthreads();
    if (wave < 4) {
        const int j = tid; const bool isw = j >= 128; const LAS bf16_t* src = isw ? (ks + (j - 128)) : (vs + j);
        float r[64];
#pragma unroll
        for (int c = 0; c < 64; ++c) { const float sc = isw ? betas[c] * __expf(gcs[c]) : betas[c]; r[c] = bf2f(src[c * 136]) * sc; }
#pragma unroll
        for (int s = 0; s < 63; ++s) {
            const float xs = r[s];
#pragma unroll
            for (int c4 = ((s + 1) & ~3); c4 < 64; c4 += 4) {
                const f32x4 l = *(const LAS f32x4*)(LT + s * 68 + c4);
                if (c4 + 0 > s) r[c4 + 0] -= l.x * xs;
                if (c4 + 1 > s) r[c4 + 1] -= l.y * xs;
                if (c4 + 2 > s) r[c4 + 2] -= l.z * xs;
                if (c4 + 3 > s) r[c4 + 3] -= l.w * xs;
            }
        }
        if (!isw) {
            const int eb = j >> 5, el = j & 31; bf16_t* ub = (bf16_t*)(cp + DNP_U);
#pragma unroll
            for (int mb = 0; mb < 2; ++mb)
#pragma unroll
                for (int hh = 0; hh < 2; ++hh) { float t[16];
#pragma unroll
                    for (int q = 0; q < 16; ++q) t[q] = r[32 * mb + 8 * (q >> 2) + 4 * hh + (q & 3)];
                    u32x4* dst = (u32x4*)(ub + ((((eb * 2 + mb) * 2 + hh) * 32 + el) * 16)); dst[0] = pack8(t); dst[1] = pack8(t + 8); }
        } else {
            const int d = j - 128; bf16_t* wb = (bf16_t*)(cp + DNP_W);
#pragma unroll
            for (int c = 0; c < 64; ++c) wb[frag_off(c, d, 8)] = (bf16_t)f2bf(r[c]);
        }
    } else {
        const int t2 = tid - 256; const float gl = gcs[63];
        bf16_t* qgb = (bf16_t*)(cp + DNP_QG); bf16_t* kgb = (bf16_t*)(cp + DNP_KGT);
#pragma unroll 2
        for (int k2 = 0; k2 < 8; ++k2) {
            { const int item = t2 + 256 * k2, c = item >> 5, d = (item & 31) * 4; const float sc = __expf(gcs[c]);
              const LAS unsigned* sp = (const LAS unsigned*)(qs + c * 136 + d); const unsigned a0 = sp[0], a1 = sp[1];
              unsigned long long o = (unsigned long long)pk2(bflo(a0) * sc, bfhi(a0) * sc) | ((unsigned long long)pk2(bflo(a1) * sc, bfhi(a1) * sc) << 32);
              *(unsigned long long*)(qgb + frag_off(c, d, 8)) = o; }
            { const int item = t2 + 256 * k2, c0 = (item >> 7) * 4, d = item & 127;
              const float v0 = bf2f(ks[(c0 + 0) * 136 + d]) * __expf(gl - gcs[c0 + 0]), v1 = bf2f(ks[(c0 + 1) * 136 + d]) * __expf(gl - gcs[c0 + 1]);
              const float v2 = bf2f(ks[(c0 + 2) * 136 + d]) * __expf(gl - gcs[c0 + 2]), v3 = bf2f(ks[(c0 + 3) * 136 + d]) * __expf(gl - gcs[c0 + 3]);
              unsigned long long o = (unsigned long long)pk2(v0, v1) | ((unsigned long long)pk2(v2, v3) << 32);
              *(unsigned long long*)(kgb + frag_off(d, c0, 4)) = o; }
        }
    }
    __syncthreads();
}

__global__ void __launch_bounds__(NTHREADS, 2) fwd_megakernel(Params p) {
    extern __shared__ __attribute__((aligned(16))) unsigned char lds_raw[];
    cg::grid_group grid = cg::this_grid();
    LAS unsigned char* lds = (LAS unsigned char*)lds_raw;
    const int G = gridDim.x, bx = blockIdx.x, NGW = G * NWAVES;
#define PHASE_IDS const int tid = opaque_tid(), lane = tid & 63, wave = __builtin_amdgcn_readfirstlane(tid >> 6), gw = bx * NWAVES + wave; (void)tid; (void)lane; (void)wave; (void)gw
    unsigned char* ws = p.ws;
    bf16_t* WIN = (bf16_t*)(ws + WS_WIN); bf16_t* WPA = (bf16_t*)(ws + WS_WPA); bf16_t* WPB = (bf16_t*)(ws + WS_WPB); bf16_t* WOUT = (bf16_t*)(ws + WS_WOUT);
    bf16_t* WUP = (bf16_t*)(ws + WS_WUP); bf16_t* WDOWN = (bf16_t*)(ws + WS_WDOWN);
    float* AB = (float*)(ws + WS_AB); float* GL = (float*)(ws + WS_GL);
    bf16_t* N1 = (bf16_t*)(p.out + (size_t)MG * DM); bf16_t* N2 = (bf16_t*)(ws + WS_N2); bf16_t* H = (bf16_t*)(ws + WS_H); unsigned char* DNP = ws + WS_DNP;
    bf16_t* U = (bf16_t*)(ws + WS_U); bf16_t* HACT = (bf16_t*)(ws + WS_HACT);

    {
        PHASE_IDS;
        LAS float* scr = (LAS float*)(lds + wave * 16384);
        constexpr int I_IN = 16 * 289, I_SQ = 16 * 32, I_UP = 16 * 176, I_DN = 44 * 32;
        constexpr int NITEMS = I_IN + 3 * I_SQ + I_UP + I_DN;
        for (int it = gw; it < NITEMS; it += NGW) {
            int r = it;
            if (r < I_IN) { const int kb = r / 289, nb = r % 289, nd = nb * 32; const int nsrc = nd < 3072 ? nd : (nd < 9216 ? nd + 16 : 3072);
                transpose_item(p.w_in, 9232, 1024, WIN, kb * 64, nsrc, nd, scr, lane); continue; } r -= I_IN;
            if (r < I_SQ) { transpose_item(p.w_proj_dn, 1024, 1024, WPA, (r / 32) * 64, (r % 32) * 32, (r % 32) * 32, scr, lane); continue; } r -= I_SQ;
            if (r < I_SQ) { transpose_item(p.w_proj_sb, 1024, 1024, WPB, (r / 32) * 64, (r % 32) * 32, (r % 32) * 32, scr, lane); continue; } r -= I_SQ;
            if (r < I_SQ) { transpose_item(p.w_out, 1024, 1024, WOUT, (r / 32) * 64, (r % 32) * 32, (r % 32) * 32, scr, lane); continue; } r -= I_SQ;
            if (r < I_UP) { transpose_item(p.ffn_w_up, FF2, 1024, WUP, (r / 176) * 64, (r % 176) * 32, (r % 176) * 32, scr, lane); continue; } r -= I_UP;
            transpose_item(p.ffn_w_down, 1024, FF, WDOWN, (r / 32) * 64, (r % 32) * 32, (r % 32) * 32, scr, lane);
        }
        for (int m = gw; m < MTOT; m += NGW) rms_row_to_bf16(p.x + (size_t)m * DM, p.norm1_w, N1 + (size_t)m * DM, lane);
    }
    grid.sync();

    for (int grp = 0; grp < NGRP; ++grp) {
        const size_t row_base = (size_t)grp * MG;
        { pg8::Gemm g{N1 + row_base * DM, WIN, MG, NIN_PAD, DM, DM}; pg8::StaticOrder S; S.init(MG, NIN_PAD, G, bx);
          Epi<1> E{H, HW, AB, nullptr}; pg8::gemm_phase(lds, g, S, E); }
        grid.sync();
        { const int tid = opaque_tid();
          for (int cidx = bx; cidx < BG * 8 * 64; cidx += G) dn_prep_chunk(p, H, AB, DNP, GL, cidx, lds, tid); }
        grid.sync();
        { PHASE_IDS;
          const int ndn = BG * 8 * 4;
          const bool dnwave = (wave == 0) && (bx < ndn);
          if (dnwave) { dn_chunk_scan_item(DNP, GL, H, bx, lane); }
          else {
              const int nblk_dn = G < ndn ? G : ndn;
              const int aw = bx < nblk_dn ? bx * 7 + (wave - 1) : nblk_dn * 7 + (bx - nblk_dn) * 8 + wave;
              const int naw = G * 8 - nblk_dn;
              LAS bf16_t* vs = (LAS bf16_t*)(lds + wave * 8704);
              for (int it = aw; it < BG * 8 * 128; it += naw) sb_attn_item(H, it, vs, lane);
          } }
        grid.sync();
        { PHASE_IDS;
        for (int it = gw; it < MG * 2; it += NGW) {
            const int T = it >> 1, h = (it & 1) * 4 + (lane >> 4), e0 = (lane & 15) * 8;
            const u32x4 ov = *(const u32x4*)(H + (size_t)T * HW + HC_DNQ + h * 128 + e0); float of[8]; unpack8(ov, of);
            bf16_t* gp = H + (size_t)T * HW + HC_DNG + h * 128 + e0; const u32x4 gv = *(const u32x4*)gp; float gf[8]; unpack8(gv, gf);
            float ss = 0.f;
#pragma unroll
            for (int j = 0; j < 8; ++j) ss += of[j] * of[j];
            ss = row16_sum(ss);
            const float r = 1.f / sqrtf(ss * (1.f / 128.f) + EPS);
            const f32x4 w0 = *(const f32x4*)(p.dn_norm_w + e0), w1 = *(const f32x4*)(p.dn_norm_w + e0 + 4);
            const float wv[8] = {w0.x, w0.y, w0.z, w0.w, w1.x, w1.y, w1.z, w1.w};
            float y[8];
#pragma unroll
            for (int j = 0; j < 8; ++j) y[j] = of[j] * r * wv[j] * (gf[j] / (1.f + __expf(-gf[j])));
            *(u32x4*)gp = pack8(y);
        } }
        grid.sync();
        { pg8::Gemm g{H + HC_DNG, WPA, MG, DM, DM, HW}; pg8::StaticOrder S; S.init(MG, DM, G, bx); Epi<2> E{H, HW, nullptr, nullptr}; pg8::gemm_phase(lds, g, S, E); }
        { pg8::Gemm g{H + HC_SBQ, WPB, MG, DM, DM, HW}; pg8::StaticOrder S; S.init(MG, DM, G, bx); Epi<3> E{H, HW, nullptr, nullptr}; pg8::gemm_phase(lds, g, S, E); }
        grid.sync();
        { pg8::Gemm g{H + HC_GDN, WOUT, MG, DM, DM, HW}; pg8::StaticOrder S; S.init(MG, DM, G, bx);
          Epi<4> E{nullptr, 0, p.out + row_base * DM, p.x + row_base * DM}; pg8::gemm_phase(lds, g, S, E); }
        grid.sync();
    }
    { PHASE_IDS; for (int m = gw; m < MTOT; m += NGW) rms_row_to_bf16(p.out + (size_t)m * DM, p.norm2_w, N2 + (size_t)m * DM, lane); }
    grid.sync();
    for (int grp = 0; grp < NGRP; ++grp) {
        const size_t row_base = (size_t)grp * MG;
        { pg8::Gemm g{N2 + row_base * DM, WUP, MG, FF2, DM, DM}; pg8::StaticOrder S; S.init(MG, FF2, G, bx); Epi<0> E{U, FF2, nullptr, nullptr}; pg8::gemm_phase(lds, g, S, E); }
        grid.sync();
        { PHASE_IDS;
        for (int it = bx * NTHREADS + tid; it < (MG / 16) * (FF / 8); it += G * NTHREADS) {
            const int cgp = it % (FF / 8), tb = it / (FF / 8), c = cgp * 8, t0 = tb * 16;
            float wg[3][8], wu[3][8];
#pragma unroll
            for (int i = 0; i < 3; ++i) {
                const f32x4 a0 = *(const f32x4*)(p.ffn_conv_w + i * FF2 + c), a1 = *(const f32x4*)(p.ffn_conv_w + i * FF2 + c + 4);
                const f32x4 b0 = *(const f32x4*)(p.ffn_conv_w + i * FF2 + FF + c), b1 = *(const f32x4*)(p.ffn_conv_w + i * FF2 + FF + c + 4);
                wg[i][0] = a0.x; wg[i][1] = a0.y; wg[i][2] = a0.z; wg[i][3] = a0.w; wg[i][4] = a1.x; wg[i][5] = a1.y; wg[i][6] = a1.z; wg[i][7] = a1.w;
                wu[i][0] = b0.x; wu[i][1] = b0.y; wu[i][2] = b0.z; wu[i][3] = b0.w; wu[i][4] = b1.x; wu[i][5] = b1.y; wu[i][6] = b1.z; wu[i][7] = b1.w;
            }
            float g2[8], g1[8], u2[8], u1[8];
            const bool first = (t0 & (SEQ - 1)) == 0;
            if (first) {
#pragma unroll
                for (int j = 0; j < 8; ++j) { g2[j] = g1[j] = u2[j] = u1[j] = 0.f; }
            } else {
                unpack8(*(const u32x4*)(U + (size_t)(t0 - 2) * FF2 + c), g2); unpack8(*(const u32x4*)(U + (size_t)(t0 - 1) * FF2 + c), g1);
                unpack8(*(const u32x4*)(U + (size_t)(t0 - 2) * FF2 + FF + c), u2); unpack8(*(const u32x4*)(U + (size_t)(t0 - 1) * FF2 + FF + c), u1);
            }
#pragma unroll 4
            for (int t = t0; t < t0 + 16; ++t) {
                float g0[8], u0[8]; unpack8(*(const u32x4*)(U + (size_t)t * FF2 + c), g0); unpack8(*(const u32x4*)(U + (size_t)t * FF2 + FF + c), u0);
                float y[8];
#pragma unroll
                for (int j = 0; j < 8; ++j) {
                    const float yg = wg[0][j] * g2[j] + wg[1][j] * g1[j] + wg[2][j] * g0[j];
                    const float yu = wu[0][j] * u2[j] + wu[1][j] * u1[j] + wu[2][j] * u0[j];
                    y[j] = yg / (1.f + __expf(-yg)) * yu;
                    g2[j] = g1[j]; g1[j] = g0[j]; u2[j] = u1[j]; u1[j] = u0[j];
                }
                *(u32x4*)(HACT + (size_t)t * FF + c) = pack8(y);
            }
        } }
        grid.sync();
        { pg8::Gemm g{HACT, WDOWN, MG, DM, FF, FF}; pg8::StaticOrder S; S.init(MG, DM, G, bx);
          Epi<4> E{nullptr, 0, p.out + row_base * DM, p.out + row_base * DM}; pg8::gemm_phase(lds, g, S, E); }
        grid.sync();
    }
    { PHASE_IDS;
    for (int m = gw; m < MTOT; m += NGW) {
        float* row = p.out + (size_t)m * DM;
        f32x4* xr = (f32x4*)row + lane; const f32x4* wr4 = (const f32x4*)p.norm_f_w + lane;
        f32x4 v[4]; float s = 0.f;
#pragma unroll
        for (int j = 0; j < 4; ++j) { v[j] = xr[64 * j]; s += (v[j].x * v[j].x + v[j].y * v[j].y) + (v[j].z * v[j].z + v[j].w * v[j].w); }
        const float rstd = 1.f / sqrtf(wave_sum(s) * (1.f / DM) + EPS);
#pragma unroll
        for (int j = 0; j < 4; ++j) { const f32x4 ww = wr4[64 * j]; xr[64 * j] = v[j] * rstd * ww; }
    } }
}

extern "C" void kernel_launch(void* const* d_in, const int* in_sizes, int n_in, void* d_out, int out_size, void* d_ws, size_t ws_size, hipStream_t stream) {
    static int grid = 0;
    if (grid == 0) {
        if (n_in != 15 || in_sizes[0] != MTOT * DM || out_size != MTOT * DM || ws_size < WS_END) {
            fprintf(stderr, "kernel_launch: unexpected shapes / workspace (n_in %d, ws %zu, need %zu); nothing launched\n", n_in, ws_size, (size_t)WS_END); grid = -1; return; }
        int dev = 0, cus = 0, per_cu = 0;
        hipGetDevice(&dev); hipDeviceGetAttribute(&cus, hipDeviceAttributeMultiprocessorCount, dev);
        if (hipFuncSetAttribute((const void*)fwd_megakernel, hipFuncAttributeMaxDynamicSharedMemorySize, LDS_BYTES) != hipSuccess) { fprintf(stderr, "kernel_launch: hipFuncSetAttribute failed\n"); grid = -1; return; }
        if (hipOccupancyMaxActiveBlocksPerMultiprocessor(&per_cu, (const void*)fwd_megakernel, NTHREADS, LDS_BYTES) != hipSuccess || per_cu < 1) { fprintf(stderr, "kernel_launch: occupancy query gave %d\n", per_cu); per_cu = 1; }
        (void)hipGetLastError();
        grid = cus * per_cu;
    }
    if (grid < 0) return;
    Params p{};
    p.x = (const float*)d_in[0]; p.norm1_w = (const float*)d_in[1]; p.w_in = (const float*)d_in[2]; p.dn_conv_w = (const float*)d_in[3]; p.dn_A_log = (const float*)d_in[4];
    p.dn_dt_bias = (const float*)d_in[5]; p.dn_norm_w = (const float*)d_in[6]; p.w_proj_dn = (const float*)d_in[7]; p.w_proj_sb = (const float*)d_in[8]; p.w_out = (const float*)d_in[9];
    p.norm2_w = (const float*)d_in[10]; p.ffn_w_up = (const float*)d_in[11]; p.ffn_conv_w = (const float*)d_in[12]; p.ffn_w_down = (const float*)d_in[13]; p.norm_f_w = (const float*)d_in[14];
    p.out = (float*)d_out; p.ws = (unsigned char*)d_ws;
    void* args[] = {&p};
    hipError_t e = hipLaunchCooperativeKernel((const void*)fwd_megakernel, dim3(grid), dim3(NTHREADS), args, LDS_BYTES, stream);
    if (e != hipSuccess) fprintf(stderr, "kernel_launch: cooperative launch failed: %s (grid %d)\n", hipGetErrorString(e), grid);
}
```
